# Optimizing an MI355X kernel written in HIP

```python
import jax, jax.numpy as jnp
from jax import lax
import numpy as np

D_MODEL = 2048
BATCH = 4
SEQ = 2048
DEPTH = 2

GRID_W = 64
CTX_LEN = 256
LRU_WIDTH = 1024
LRU_BLOCKS = 8
LRU_BLOCK_W = LRU_WIDTH // LRU_BLOCKS
LRU_C = 8.0
CONV_W = 4
MLA_HEADS = 8
MLA_Q_RANK = 512
MLA_KV_RANK = 256
MLA_NOPE = 128
MLA_ROPE = 64
MLA_V = 128
MLA_SCALE = (MLA_NOPE + MLA_ROPE) ** -0.5
SWA_HEADS = 16
SWA_KV_HEADS = 4
SWA_HEAD_DIM = 64
SWA_REP = SWA_HEADS // SWA_KV_HEADS
SWA_SCALE = SWA_HEAD_DIM ** -0.5
WINDOW = 128
BLOCK = 128
N_BRANCH = 3
BRANCH_W = 1024
MIX_COLS = (LRU_WIDTH, LRU_WIDTH, MLA_Q_RANK, MLA_KV_RANK, MLA_ROPE,
            SWA_HEADS * SWA_HEAD_DIM, SWA_KV_HEADS * SWA_HEAD_DIM, SWA_KV_HEADS * SWA_HEAD_DIM)
MIX_IN = 4416
IN_COLS = MIX_IN + N_BRANCH * D_MODEL
FFN_HIDDEN = -(-8 * D_MODEL // (3 * 256)) * 256
ROPE_BASE = 10000.0
LN_EPS = 1e-5
RMS_EPS = 1e-6

kernel_name = 'hybrid_rglru_mla_swa_deepnorm_dit'

F32 = jnp.float32


def _layer_norm(x, g, b):
    xf = x.astype(F32)
    mu = jnp.mean(xf, -1, keepdims=True)
    var = jnp.mean(jnp.square(xf - mu), -1, keepdims=True)
    return ((xf - mu) * lax.rsqrt(var + LN_EPS) * g.astype(F32) + b.astype(F32)).astype(x.dtype)


def _rms_norm(x, g):
    xf = x.astype(F32)
    return (xf * lax.rsqrt(jnp.mean(xf * xf, -1, keepdims=True) + RMS_EPS) * g.astype(F32)).astype(x.dtype)


def _axial_angles(rows, rot_dim):
    row = jnp.repeat(jnp.arange(rows, dtype=F32), GRID_W)
    col = jnp.tile(jnp.arange(GRID_W, dtype=F32), rows)
    half = rot_dim // 2
    inv = ROPE_BASE ** (-jnp.arange(0, half, 2, dtype=F32) / half)
    return row[:, None] * inv, col[:, None] * inv


def _rope_1d(x, ang):
    f = ang.shape[-1]
    cos = jnp.cos(ang)[None, :, None, :]
    sin = jnp.sin(ang)[None, :, None, :]
    x1 = x[..., :f].astype(F32)
    x2 = x[..., f:].astype(F32)
    return jnp.concatenate([x1 * cos - x2 * sin, x1 * sin + x2 * cos], -1).astype(x.dtype)


def _axial_rope(x, ang_row, ang_col):
    half = x.shape[-1] // 2
    return jnp.concatenate([_rope_1d(x[..., :half], ang_row), _rope_1d(x[..., half:], ang_col)], -1)


def _centred_dwconv(x, w, b):
    t = x.shape[1]
    left = CONV_W // 2
    xp = jnp.pad(x, ((0, 0), (left, CONV_W - 1 - left), (0, 0)))
    out = xp[:, 0:t] * w[0]
    for k in range(1, CONV_W):
        out = out + xp[:, k:k + t] * w[k]
    return out + b


def _blockdiag(x, w, b):
    xb = x.reshape(x.shape[:-1] + (LRU_BLOCKS, LRU_BLOCK_W))
    return (jnp.einsum('btnj,njk->btnk', xb, w) + b).reshape(x.shape)


def _lru_coeffs(x, wr, br, wi, bi, lam):
    r = jax.nn.sigmoid(_blockdiag(x, wr, br).astype(F32))
    i = jax.nn.sigmoid(_blockdiag(x, wi, bi).astype(F32))
    log_a = -LRU_C * r * jax.nn.softplus(-lam.astype(F32))
    a = jnp.exp(log_a)
    mult = jnp.sqrt(-jnp.expm1(2.0 * log_a))
    return a, mult * i * x.astype(F32)


def _lin_combine(left, right):
    a_l, b_l = left
    a_r, b_r = right
    return a_l * a_r, a_r * b_l + b_r


def _linear_scan(a, b, h0):
    b = b.at[:, 0].add(a[:, 0] * h0)
    return lax.associative_scan(_lin_combine, (a, b), axis=1)[1]


def _rglru(xl, xc, lp):
    xl = _centred_dwconv(xl, lp['conv_w'], lp['conv_b'])
    xc = _centred_dwconv(xc, lp['conv_w'], lp['conv_b'])
    h0 = jnp.zeros((xl.shape[0], xl.shape[2]), F32)
    rev = lambda t: jnp.flip(t, axis=1)
    hs_l, hs_c = [], []
    for d in range(2):
        prm = (lp['lru_wr'][d], lp['lru_br'][d], lp['lru_wi'][d], lp['lru_bi'][d], lp['lru_lambda'][d])
        a_c, b_c = _lru_coeffs(xc, *prm)
        a_l, b_l = _lru_coeffs(xl, *prm)
        if d == 1:
            a_c, b_c, a_l, b_l = rev(a_c), rev(b_c), rev(a_l), rev(b_l)
        s_c = _linear_scan(a_c, b_c, h0)
        s_l = _linear_scan(a_l, b_l, s_c[:, -1])
        if d == 1:
            s_c, s_l = rev(s_c), rev(s_l)
        hs_l.append(s_l)
        hs_c.append(s_c)
    return hs_l[0] + hs_l[1], hs_c[0] + hs_c[1]


def _mla_q(q_lin, lp, ang):
    bsz, t, _ = q_lin.shape
    q = (_rms_norm(q_lin, lp['mla_q_norm']) @ lp['mla_w_q_up']).reshape(bsz, t, MLA_HEADS, MLA_NOPE + MLA_ROPE)
    q_nope, q_rope = q[..., :MLA_NOPE], q[..., MLA_NOPE:]
    if ang is not None:
        q_rope = _axial_rope(q_rope, *ang)
    return jnp.concatenate([q_nope, q_rope], -1)


def _mla_kv(kv_lin, kr_lin, lp, ang):
    bsz, t, _ = kv_lin.shape
    kv = (_rms_norm(kv_lin, lp['mla_kv_norm']) @ lp['mla_w_kv_up']).reshape(bsz, t, MLA_HEADS, MLA_NOPE + MLA_V)
    k_nope, v = kv[..., :MLA_NOPE], kv[..., MLA_NOPE:]
    k_rope = kr_lin[:, :, None, :]
    if ang is not None:
        k_rope = _axial_rope(k_rope, *ang)
    k = jnp.concatenate([k_nope, jnp.broadcast_to(k_rope, (bsz, t, MLA_HEADS, MLA_ROPE))], -1)
    return k, v


def _softmax_attend(q, k, v, scale):
    s = jnp.einsum('bqhd,bkhd->bhqk', q, k).astype(F32) * scale
    p = jax.nn.softmax(s, axis=-1).astype(v.dtype)
    return jnp.einsum('bhqk,bkhd->bqhd', p, v)


def _blocked_attend(q, k, v, scale):
    bsz, t, h, dk = q.shape
    nb = t // BLOCK
    qb = jnp.moveaxis(q.reshape(bsz, nb, BLOCK, h, dk), 1, 0)
    out = lax.map(lambda qi: _softmax_attend(qi, k, v, scale), qb)
    return jnp.moveaxis(out, 0, 1).reshape(bsz, t, h * v.shape[-1])


def _swa_latent(q, k, v, kc, vc, sinks):
    bsz, s, _, d = q.shape
    g, r, nb = SWA_KV_HEADS, SWA_REP, s // BLOCK
    qb = q.reshape(bsz, nb, BLOCK, g, r, d)

    def band(t):
        tp = jnp.pad(t, ((0, 0), (BLOCK, BLOCK), (0, 0), (0, 0))).reshape(bsz, nb + 2, BLOCK, g, d)
        return jnp.concatenate([tp[:, :-2], tp[:, 1:-1], tp[:, 2:]], axis=2)

    kb, vb = band(k), band(v)
    s_band = jnp.einsum('bnqgrd,bnkgd->bgrnqk', qb, kb).astype(F32) * SWA_SCALE
    qpos = jnp.arange(nb)[:, None, None] * BLOCK + jnp.arange(BLOCK)[None, :, None]
    kpos = jnp.arange(nb)[:, None, None] * BLOCK - BLOCK + jnp.arange(3 * BLOCK)[None, None, :]
    valid = (jnp.abs(kpos - qpos) <= WINDOW) & (kpos >= 0) & (kpos < s)
    s_band = jnp.where(valid, s_band, -jnp.inf)
    s_ctx = jnp.einsum('bnqgrd,bcgd->bgrnqc', qb, kc).astype(F32) * SWA_SCALE
    sink = jnp.broadcast_to(sinks.astype(F32).reshape(g, r)[None, :, :, None, None, None], s_ctx.shape[:-1] + (1,))
    p = jax.nn.softmax(jnp.concatenate([sink, s_ctx, s_band], -1), axis=-1)
    n_ctx = kc.shape[1]
    p_ctx = p[..., 1:1 + n_ctx].astype(v.dtype)
    p_band = p[..., 1 + n_ctx:].astype(v.dtype)
    out = (jnp.einsum('bgrnqc,bcgd->bnqgrd', p_ctx, vc)
           + jnp.einsum('bgrnqk,bnkgd->bnqgrd', p_band, vb))
    return out.reshape(bsz, s, SWA_HEADS * d)


def _swa_context(qc, kc, vc, sinks):
    bsz, n_ctx, _, d = qc.shape
    g, r = SWA_KV_HEADS, SWA_REP
    qg = qc.reshape(bsz, n_ctx, g, r, d)
    s = jnp.einsum('bqgrd,bkgd->bgrqk', qg, kc).astype(F32) * SWA_SCALE
    sink = jnp.broadcast_to(sinks.astype(F32).reshape(g, r)[None, :, :, None, None], s.shape[:-1] + (1,))
    p = jax.nn.softmax(jnp.concatenate([sink, s], -1), axis=-1)[..., 1:].astype(vc.dtype)
    return jnp.einsum('bgrqk,bkgd->bqgrd', p, vc).reshape(bsz, n_ctx, SWA_HEADS * d)


def _merge(gate_lin, ys, w_branch, w_out):
    yst = jnp.stack(ys, axis=2)
    z = jnp.einsum('btnw,nwd->btnd', yst, w_branch)
    gates = jax.nn.sigmoid(gate_lin.reshape(z.shape).astype(F32)).astype(z.dtype)
    return jnp.sum(gates * z, axis=2) @ w_out


def _mixer(u, uc, ang_mla, ang_swa, lp, need_ctx):
    bsz, s, _ = u.shape
    n_ctx = uc.shape[1]
    g, d = SWA_KV_HEADS, SWA_HEAD_DIM
    split_at = np.cumsum(MIX_COLS)[:-1].tolist()
    proj = u @ lp['w_in']
    projc = uc @ lp['w_in'][:, :MIX_IN]
    a_x, a_g, b_q, b_kv, b_kr, c_q, c_k, c_v = jnp.split(proj[..., :MIX_IN], split_at, axis=-1)
    a_xc, a_gc, b_qc, b_kvc, b_krc, c_qc, c_kc, c_vc = jnp.split(projc, split_at, axis=-1)

    h_l, h_c = _rglru(a_x, a_xc, lp)
    y_a = (h_l * jax.nn.gelu(a_g.astype(F32))).astype(u.dtype)

    k_b, v_b = _mla_kv(b_kv, b_kr, lp, ang_mla)
    kc_b, vc_b = _mla_kv(b_kvc, b_krc, lp, None)
    q_b = _mla_q(b_q, lp, ang_mla)
    y_b = _blocked_attend(q_b, jnp.concatenate([kc_b, k_b], 1), jnp.concatenate([vc_b, v_b], 1), MLA_SCALE)

    q_c = _axial_rope(c_q.reshape(bsz, s, SWA_HEADS, d), *ang_swa)
    k_c = _axial_rope(c_k.reshape(bsz, s, g, d), *ang_swa)
    v_c = c_v.reshape(bsz, s, g, d)
    kc_c = c_kc.reshape(bsz, n_ctx, g, d)
    vc_c = c_vc.reshape(bsz, n_ctx, g, d)
    y_c = _swa_latent(q_c, k_c, v_c, kc_c, vc_c, lp['swa_sinks'])

    y = _merge(proj[..., MIX_IN:], (y_a, y_b.astype(u.dtype), y_c.astype(u.dtype)), lp['w_branch'], lp['w_out'])
    if not need_ctx:
        return y, None
    yc_a = (h_c * jax.nn.gelu(a_gc.astype(F32))).astype(uc.dtype)
    qc_b = _mla_q(b_qc, lp, None)
    yc_b = _softmax_attend(qc_b, kc_b, vc_b, MLA_SCALE).reshape(bsz, n_ctx, MLA_HEADS * MLA_V)
    yc_c = _swa_context(c_qc.reshape(bsz, n_ctx, SWA_HEADS, d), kc_c, vc_c, lp['swa_sinks'])
    yc = _merge(uc @ lp['w_in'][:, MIX_IN:], (yc_a, yc_b.astype(uc.dtype), yc_c.astype(uc.dtype)),
                lp['w_branch'], lp['w_out'])
    return y, yc


def _swiglu(u, w_in, w_out):
    gt, up = jnp.split(u @ w_in, 2, axis=-1)
    return (jax.nn.silu(gt) * up) @ w_out


def setup_inputs(seed: int = 0) -> dict:
    key = jax.random.key(seed)
    ks = iter(jax.random.split(key, 32))

    def nrm(shape, scale):
        return jax.random.normal(next(ks), shape, F32) * scale

    beta = (8 * DEPTH) ** -0.25
    a_c = jax.random.uniform(next(ks), (DEPTH, 2, LRU_WIDTH), F32, minval=0.9, maxval=0.999)
    sg = a_c ** (1.0 / LRU_C)
    lam = jnp.log(sg) - jnp.log1p(-sg)
    return {
        'x': nrm((BATCH, SEQ, D_MODEL), 1.0),
        'c': nrm((BATCH, D_MODEL), 1.0),
        'ctx': nrm((BATCH, CTX_LEN, D_MODEL), 1.0),
        'c_ctx': nrm((D_MODEL,), 1.0),
        'w_ada': nrm((DEPTH, D_MODEL, 6 * D_MODEL), 0.5 * D_MODEL ** -0.5),
        'b_ada': nrm((DEPTH, 6 * D_MODEL), 0.01),
        'w_in': nrm((DEPTH, D_MODEL, IN_COLS), D_MODEL ** -0.5),
        'conv_w': nrm((DEPTH, CONV_W, LRU_WIDTH), CONV_W ** -0.5),
        'conv_b': nrm((DEPTH, LRU_WIDTH), 0.01),
        'lru_wr': nrm((DEPTH, 2, LRU_BLOCKS, LRU_BLOCK_W, LRU_BLOCK_W), LRU_BLOCK_W ** -0.5),
        'lru_br': nrm((DEPTH, 2, LRU_BLOCKS, LRU_BLOCK_W), 0.01),
        'lru_wi': nrm((DEPTH, 2, LRU_BLOCKS, LRU_BLOCK_W, LRU_BLOCK_W), LRU_BLOCK_W ** -0.5),
        'lru_bi': nrm((DEPTH, 2, LRU_BLOCKS, LRU_BLOCK_W), 0.01),
        'lru_lambda': lam,
        'mla_q_norm': 1.0 + nrm((DEPTH, MLA_Q_RANK), 0.02),
        'mla_w_q_up': nrm((DEPTH, MLA_Q_RANK, MLA_HEADS * (MLA_NOPE + MLA_ROPE)), MLA_Q_RANK ** -0.5),
        'mla_kv_norm': 1.0 + nrm((DEPTH, MLA_KV_RANK), 0.02),
        'mla_w_kv_up': nrm((DEPTH, MLA_KV_RANK, MLA_HEADS * (MLA_NOPE + MLA_V)), MLA_KV_RANK ** -0.5),
        'swa_sinks': nrm((DEPTH, SWA_HEADS), 0.5),
        'w_branch': nrm((DEPTH, N_BRANCH, BRANCH_W, D_MODEL), BRANCH_W ** -0.5),
        'w_out': nrm((DEPTH, D_MODEL, D_MODEL), beta * D_MODEL ** -0.5),
        'ln1_g': 1.0 + nrm((DEPTH, D_MODEL), 0.02),
        'ln1_b': nrm((DEPTH, D_MODEL), 0.02),
        'w_ffn_in': nrm((DEPTH, D_MODEL, 2 * FFN_HIDDEN), D_MODEL ** -0.5),
        'w_ffn_out': nrm((DEPTH, FFN_HIDDEN, D_MODEL), beta * FFN_HIDDEN ** -0.5),
        'ln2_g': 1.0 + nrm((DEPTH, D_MODEL), 0.02),
        'ln2_b': nrm((DEPTH, D_MODEL), 0.02),
    }


def reference(x, c, ctx, c_ctx, w_ada, b_ada, w_in, conv_w, conv_b, lru_wr, lru_br, lru_wi, lru_bi,
              lru_lambda, mla_q_norm, mla_w_q_up, mla_kv_norm, mla_w_kv_up, swa_sinks, w_branch, w_out,
              ln1_g, ln1_b, w_ffn_in, w_ffn_out, ln2_g, ln2_b):
    alpha = (2 * DEPTH) ** 0.25
    rows = x.shape[1] // GRID_W
    ang_mla = _axial_angles(rows, MLA_ROPE)
    ang_swa = _axial_angles(rows, SWA_HEAD_DIM)
    c_act = jax.nn.silu(c)
    cc_act = jax.nn.silu(c_ctx)
    for l in range(DEPTH):
        need_ctx = l < DEPTH - 1
        lp = {
            'w_in': w_in[l], 'conv_w': conv_w[l], 'conv_b': conv_b[l],
            'lru_wr': lru_wr[l], 'lru_br': lru_br[l], 'lru_wi': lru_wi[l], 'lru_bi': lru_bi[l],
            'lru_lambda': lru_lambda[l], 'mla_q_norm': mla_q_norm[l], 'mla_w_q_up': mla_w_q_up[l],
            'mla_kv_norm': mla_kv_norm[l], 'mla_w_kv_up': mla_w_kv_up[l], 'swa_sinks': swa_sinks[l],
            'w_branch': w_branch[l], 'w_out': w_out[l],
        }
        ada = c_act @ w_ada[l] + b_ada[l]
        adac = cc_act @ w_ada[l] + b_ada[l]
        sh1, sc1, g1, sh2, sc2, g2 = jnp.split(ada[:, None, :], 6, axis=-1)
        sh1c, sc1c, g1c, sh2c, sc2c, g2c = jnp.split(adac, 6, axis=-1)

        u = x * (1.0 + sc1) + sh1
        uc = ctx * (1.0 + sc1c) + sh1c
        y, yc = _mixer(u, uc, ang_mla, ang_swa, lp, need_ctx)
        x = _layer_norm(alpha * x + g1 * y, ln1_g[l], ln1_b[l])
        x = _layer_norm(alpha * x + g2 * _swiglu(x * (1.0 + sc2) + sh2, w_ffn_in[l], w_ffn_out[l]),
                        ln2_g[l], ln2_b[l])
        if need_ctx:
            ctx = _layer_norm(alpha * ctx + g1c * yc, ln1_g[l], ln1_b[l])
            ctx = _layer_norm(alpha * ctx + g2c * _swiglu(ctx * (1.0 + sc2c) + sh2c, w_ffn_in[l], w_ffn_out[l]),
                              ln2_g[l], ln2_b[l])
    return x
```

```cpp
#include <hip/hip_runtime.h>
#include <hip/hip_cooperative_groups.h>
#include <cstdio>
#include <cstdint>
namespace cg = cooperative_groups;

#define LAS __attribute__((address_space(3)))
typedef unsigned short bf16_t;
typedef short bf16x8 __attribute__((ext_vector_type(8)));
typedef float f32x4 __attribute__((ext_vector_type(4)));
typedef float f32x2 __attribute__((ext_vector_type(2)));
typedef unsigned u32x4 __attribute__((ext_vector_type(4)));
typedef unsigned u32x2 __attribute__((ext_vector_type(2)));

constexpr int DM = 2048, NBATCH = 4, SEQ = 2048, CTXL = 256;
constexpr int CR = NBATCH * CTXL;
constexpr int MR = CR + NBATCH * SEQ;
constexpr int INC = 10560, LDP = 10752;
constexpr int FF = 5632;
constexpr int NTH = 512;
constexpr float ALPHA = 1.41421356237f;
constexpr float LOG2E = 1.44269504089f;

constexpr size_t SZ_WIN = (size_t)LDP * 2048 * 2, SZ_WQ = (size_t)1536 * 512 * 2, SZ_WK = (size_t)1024 * 256 * 2, SZ_WV = SZ_WK;
constexpr size_t SZ_WLRU = (size_t)2 * 2 * 8 * 128 * 128 * 2, SZ_WBR = (size_t)3 * 2048 * 1024 * 2, SZ_WOUT = (size_t)2048 * 2048 * 2;
constexpr size_t SZ_WF1 = (size_t)11264 * 2048 * 2, SZ_WF2 = (size_t)2048 * 5632 * 2;
constexpr size_t OW_IN = 0, OW_Q = OW_IN + SZ_WIN, OW_K = OW_Q + SZ_WQ, OW_V = OW_K + SZ_WK, OW_LRU = OW_V + SZ_WV, OW_BR = OW_LRU + SZ_WLRU,
                 OW_OUT = OW_BR + SZ_WBR, OW_F1 = OW_OUT + SZ_WOUT, OW_F2 = OW_F1 + SZ_WF1, W_LAYER = OW_F2 + SZ_WF2;
constexpr size_t WS_PROJ = 2 * W_LAYER;
constexpr size_t WS_XV = WS_PROJ + (size_t)MR * LDP * 2;
constexpr size_t WS_U = WS_XV + (size_t)MR * 2048 * 4;
constexpr size_t WS_Y = WS_U + (size_t)MR * 2048 * 2;
constexpr size_t WS_QB = WS_Y + (size_t)MR * 3072 * 2;
constexpr size_t WS_KN = WS_QB + (size_t)MR * 1536 * 2;
constexpr size_t WS_VT = WS_KN + (size_t)MR * 1024 * 2;
constexpr size_t WS_SVT = WS_VT + (size_t)MR * 1024 * 2;
constexpr size_t WS_MB = WS_SVT + (size_t)MR * 256 * 2;
constexpr size_t WS_ADA = WS_MB + (size_t)MR * 2048 * 2;
constexpr size_t WS_RMS = WS_ADA + (size_t)2 * 5 * 12288 * 4;
constexpr size_t WS_SUM = WS_RMS + (size_t)MR * 12 * 4;
constexpr size_t WS_ROPE = WS_SUM + (size_t)2 * 144 * 1024 * 8;
constexpr size_t WS_BAR = WS_ROPE + 64 * 16 * 8;
constexpr size_t WS_END = WS_BAR + 16384;

constexpr int LDS_BYTES = 131072 + 64;

struct Args { const float* in[27]; float* out; unsigned char* ws; int ph_lo, ph_hi; };

__device__ __forceinline__ unsigned cvt_pk_bf16(float lo, float hi) { unsigned r; asm volatile("v_cvt_pk_bf16_f32 %0, %1, %2" : "=v"(r) : "v"(lo), "v"(hi)); return r; }
__device__ __forceinline__ float bflo(unsigned w) { return __uint_as_float(w << 16); }
__device__ __forceinline__ float bfhi(unsigned w) { return __uint_as_float(w & 0xffff0000u); }
__device__ __forceinline__ float bf2f(bf16_t v) { return __uint_as_float((unsigned)v << 16); }
__device__ __forceinline__ float sigmoidf_(float x) { return 1.0f / (1.0f + __expf(-x)); }
__device__ __forceinline__ float wave_sum(float v) {
#pragma unroll
    for (int o = 32; o >= 1; o >>= 1) v += __shfl_xor(v, o);
    return v;
}
__device__ __forceinline__ float xmax16(float x) { const unsigned u = __float_as_uint(x); auto r = __builtin_amdgcn_permlane16_swap(u, u, false, false); return fmaxf(__uint_as_float(r[0]), __uint_as_float(r[1])); }
__device__ __forceinline__ float xmax32(float x) { const unsigned u = __float_as_uint(x); auto r = __builtin_amdgcn_permlane32_swap(u, u, false, false); return fmaxf(__uint_as_float(r[0]), __uint_as_float(r[1])); }
__device__ __forceinline__ int opaque_tid() { int t = threadIdx.x; asm volatile("" : "+v"(t)); return t; }
__device__ __forceinline__ int ada_row(int R) { return R < CR ? 4 : (R - CR) >> 11; }

namespace pg8 {
constexpr int BM = 256, BK = 64, HALF = 128, HTB = HALF * BK * 2, STAGE_BYTES = 8 * HTB;
__device__ __forceinline__ int lds_byte(int r, int c) { const int st = (r >> 4) * 2 + (c >> 5), rr = r & 15, cc = c & 31, ob = rr * 64 + cc * 2; return st * 1024 + (ob ^ (((ob >> 9) & 1) << 5)); }
__device__ __forceinline__ void stage_rc(int b, int& R, int& C) { const int st = b / 1024, sb = b % 1024, swz = sb ^ (((sb >> 9) & 1) << 5); R = (st >> 1) * 16 + swz / 64; C = (st & 1) * 32 + (swz % 64) / 2; }
__device__ __forceinline__ int perm32(int rho) { const int n = rho >> 4, i = rho & 15; return 8 * (i >> 2) + 4 * n + (i & 3); }

struct Unit { int pm, pn, z; };
struct Gemm { const bf16_t* A; const bf16_t* Bt; int lda, ldb, K; long zA, zB; };

struct Order {
    int nM, nN, pm0, pn0, nwg;
    __device__ __forceinline__ void init(int nM_, int nN_, int pm0_, int pn0_) { nM = nM_; nN = nN_; pm0 = pm0_; pn0 = pn0_; nwg = nM_ * nN_; }
    __device__ __forceinline__ void map(int L, Unit& u) const {
        int wgid = L; { const int q = nwg / 8, r = nwg % 8, xcd = wgid % 8, off = wgid / 8; wgid = (xcd < r ? xcd * (q + 1) : r * (q + 1) + (xcd - r) * q) + off; }
        const int nig = 8 * nN, gid = wgid / nig, fm = gid * 8, gsz = (nM - fm) < 8 ? (nM - fm) : 8;
        u.pm = pm0 + fm + ((wgid % nig) % gsz); u.pn = pn0 + (wgid % nig) / gsz;
    }
};
template <int ZREP, bool ZSPREAD = false> struct Sched {
    Order a, b; int G, c;
    __device__ __forceinline__ bool next(int i, Unit& u) const {
        if (ZSPREAD) { const int L = i * G + c; if (L >= a.nwg * ZREP) return false; const int t = L / ZREP; u.z = L - t * ZREP; a.map(t, u); return true; }
        const int rnd = i / ZREP; u.z = i - rnd * ZREP; int L = rnd * G + c;
        if (L < a.nwg) { a.map(L, u); return true; }
        L -= a.nwg; if (L < b.nwg) { b.map(L, u); return true; }
        return false;
    }
};

template <class Epi, class SchedT>
__device__ __forceinline__ void gemm_phase(LAS unsigned char* lds, const Gemm g, const SchedT& S, const Epi& E) {
    const int tid = opaque_tid(), wid = __builtin_amdgcn_readfirstlane(tid >> 6), lane = tid & 63, wr = wid >> 2, wc = wid & 3, fr = lane & 15, fq = lane >> 4;
    int K = g.K; asm volatile("" : "+s"(K)); const int nt = K / BK;
    unsigned voffA[2], voffB[2];
#pragma unroll
    for (int i = 0; i < 2; ++i) { int R, C; stage_rc(tid * 16 + i * 8192, R, C); const int Rb = Epi::PERM ? ((R & ~31) + perm32(R & 31)) : R;
        voffA[i] = (unsigned)(R * g.lda + C) * 2u; voffB[i] = (unsigned)(Rb * g.ldb + C) * 2u; }
    const size_t kstep = (size_t)(BK * 2);
    const size_t hstepA = (size_t)HALF * g.lda * 2, hstepB = (size_t)HALF * g.ldb * 2;
    const size_t tstepA = 2 * hstepA, tstepB = 2 * hstepB;
    const unsigned ldsw = (unsigned)wid * 1024u;
    const int aoff = lds_byte(wr * 64 + fr, fq * 8), boff = lds_byte(wc * 32 + fr, fq * 8);
#define PG8_SA(b, h) (((b) * 2 + (h)) * HTB)
#define PG8_SB(b, h) ((4 + (b) * 2 + (h)) * HTB)
#define PG8_STAGE(bufoff, gbase, voff) do { _Pragma("unroll") for (int _i = 0; _i < 2; ++_i) \
        __builtin_amdgcn_global_load_lds((const unsigned*)((const char*)(gbase) + (voff)[_i]), (LAS unsigned*)(lds + (bufoff) + ldsw + _i * 8192), 16, 0, 0); } while (0)
#define PG8_LDA(dst, b, h) do { _Pragma("unroll") for (int m = 0; m < 4; ++m) _Pragma("unroll") for (int k = 0; k < 2; ++k) dst[m][k] = *(const LAS bf16x8*)(lds + PG8_SA(b, h) + aoff + m * 2048 + k * 1024); } while (0)
#define PG8_LDB(dst, b, h) do { _Pragma("unroll") for (int n = 0; n < 2; ++n) _Pragma("unroll") for (int k = 0; k < 2; ++k) dst[n][k] = *(const LAS bf16x8*)(lds + PG8_SB(b, h) + boff + n * 2048 + k * 1024); } while (0)
#define PG8_MMA(ai, bj, At, Bt) do { __builtin_amdgcn_s_setprio(1); _Pragma("unroll") for (int m = 0; m < 4; ++m) _Pragma("unroll") for (int n = 0; n < 2; ++n) _Pragma("unroll") for (int k = 0; k < 2; ++k) \
        acc[ai][bj][m][n] = __builtin_amdgcn_mfma_f32_16x16x32_bf16(Bt[n][k], At[m][k], acc[ai][bj][m][n], 0, 0, 0); __builtin_amdgcn_s_setprio(0); } while (0)
#define PG8_WAIT_V(n) asm volatile("s_waitcnt vmcnt(" #n ")" ::: "memory")
#define PG8_WAIT_L(n) asm volatile("s_waitcnt lgkmcnt(" #n ")" ::: "memory")
#define PG8_BAR __builtin_amdgcn_s_barrier()
#define PG8_SCHED __builtin_amdgcn_sched_barrier(0)
    Unit cur, nxt; int ui = 0;
    if (!S.next(0, cur)) return;
    f32x4 acc[2][2][4][2];
#pragma unroll
    for (int a = 0; a < 2; ++a)
#pragma unroll
        for (int b = 0; b < 2; ++b)
#pragma unroll
            for (int m = 0; m < 4; ++m)
#pragma unroll
                for (int n = 0; n < 2; ++n) acc[a][b][m][n] = (f32x4){0.f, 0.f, 0.f, 0.f};
    bf16x8 At[4][2], B0[2][2], B1[2][2];
    const char* cA = (const char*)g.A + (long)cur.z * g.zA + (size_t)cur.pm * tstepA; const char* cB = (const char*)g.Bt + (long)cur.z * g.zB + (size_t)cur.pn * tstepB;
    PG8_STAGE(PG8_SB(0, 0), cB, voffB); PG8_STAGE(PG8_SB(0, 1), cB + hstepB, voffB); PG8_STAGE(PG8_SA(0, 0), cA, voffA); PG8_STAGE(PG8_SA(0, 1), cA + hstepA, voffA);
    if (wr == 1) PG8_BAR;
    PG8_WAIT_V(2); PG8_BAR;
    PG8_STAGE(PG8_SB(1, 0), cB + kstep, voffB); PG8_STAGE(PG8_SA(1, 0), cA + kstep, voffA); PG8_STAGE(PG8_SB(1, 1), cB + hstepB + kstep, voffB);
    PG8_WAIT_V(6); PG8_BAR;
    for (;;) {
        const bool has_next = S.next(ui + 1, nxt);
        const char* nA = has_next ? (const char*)g.A + (long)nxt.z * g.zA + (size_t)nxt.pm * tstepA : cA; const char* nB = has_next ? (const char*)g.Bt + (long)nxt.z * g.zB + (size_t)nxt.pn * tstepB : cB;
        for (int t = 0; t < nt; t += 2) {
            const bool last = (t == nt - 2);
            const char* a1 = cA + (size_t)(t + 1) * kstep;
            const char* a2 = last ? nA : cA + (size_t)(t + 2) * kstep; const char* b2 = last ? nB : cB + (size_t)(t + 2) * kstep;
            const char* a3 = a2 + kstep; const char* b3 = b2 + kstep;
            PG8_LDB(B0, 0, 0); PG8_LDB(B1, 0, 1); PG8_SCHED; PG8_LDA(At, 0, 0); PG8_STAGE(PG8_SA(1, 1), a1 + hstepA, voffA);
            PG8_WAIT_V(8); PG8_WAIT_L(0); PG8_BAR; PG8_MMA(0, 0, At, B0); PG8_MMA(0, 1, At, B1); PG8_BAR; PG8_SCHED;
            PG8_LDA(At, 0, 1); PG8_STAGE(PG8_SB(0, 0), b2, voffB); PG8_STAGE(PG8_SB(0, 1), b2 + hstepB, voffB); PG8_STAGE(PG8_SA(0, 0), a2, voffA);
            PG8_WAIT_V(8); PG8_WAIT_L(0); PG8_BAR; PG8_MMA(1, 0, At, B0); PG8_MMA(1, 1, At, B1); PG8_BAR; PG8_SCHED;
            PG8_LDB(B0, 1, 0); PG8_LDB(B1, 1, 1); PG8_SCHED; PG8_LDA(At, 1, 0); PG8_STAGE(PG8_SA(0, 1), a2 + hstepA, voffA);
            PG8_WAIT_V(8); PG8_WAIT_L(0); PG8_BAR; PG8_MMA(0, 0, At, B0); PG8_MMA(0, 1, At, B1); PG8_BAR; PG8_SCHED;
            PG8_LDA(At, 1, 1); PG8_STAGE(PG8_SB(1, 0), b3, voffB); PG8_STAGE(PG8_SB(1, 1), b3 + hstepB, voffB); PG8_STAGE(PG8_SA(1, 0), a3, voffA);
            PG8_WAIT_V(8); PG8_WAIT_L(0); PG8_BAR; PG8_MMA(1, 0, At, B0); PG8_MMA(1, 1, At, B1); PG8_BAR; PG8_SCHED;
        }
        if (wr == 0) PG8_BAR;
        E(acc, cur, wr, wc, fr, fq);
        if (!has_next) break;
#pragma unroll
        for (int a = 0; a < 2; ++a)
#pragma unroll
            for (int b = 0; b < 2; ++b)
#pragma unroll
                for (int m = 0; m < 4; ++m)
#pragma unroll
                    for (int n = 0; n < 2; ++n) acc[a][b][m][n] = (f32x4){0.f, 0.f, 0.f, 0.f};
        cur = nxt; cA = nA; cB = nB; ++ui;
        if (wr == 1) PG8_BAR;
    }
    PG8_WAIT_V(0);
    PG8_BAR;
#undef PG8_SA
#undef PG8_SB
#undef PG8_STAGE
#undef PG8_LDA
#undef PG8_LDB
#undef PG8_MMA
#undef PG8_WAIT_V
#undef PG8_WAIT_L
#undef PG8_BAR
#undef PG8_SCHED
}

typedef f32x4 AccT[2][2][4][2];

__device__ __forceinline__ void rope4(f32x4& v0, f32x4& v1, const float* rope, int pos, int fq) {
    const f32x4* rp = (const f32x4*)(rope + (pos * 16 + 4 * fq) * 2);
    const f32x4 c01 = rp[0], c23 = rp[1];
    f32x4 a = v0, b = v1;
    v0[0] = a[0] * c01[0] - b[0] * c01[1]; v1[0] = a[0] * c01[1] + b[0] * c01[0];
    v0[1] = a[1] * c01[2] - b[1] * c01[3]; v1[1] = a[1] * c01[3] + b[1] * c01[2];
    v0[2] = a[2] * c23[0] - b[2] * c23[1]; v1[2] = a[2] * c23[1] + b[2] * c23[0];
    v0[3] = a[3] * c23[2] - b[3] * c23[3]; v1[3] = a[3] * c23[3] + b[3] * c23[2];
}
__device__ __forceinline__ u32x2 pack4(f32x4 v) { u32x2 w; w.x = cvt_pk_bf16(v[0], v[1]); w.y = cvt_pk_bf16(v[2], v[3]); return w; }
__device__ __forceinline__ u32x4 pack8(f32x4 v0, f32x4 v1) { u32x4 w; w.x = cvt_pk_bf16(v0[0], v0[1]); w.y = cvt_pk_bf16(v0[2], v0[3]); w.z = cvt_pk_bf16(v1[0], v1[1]); w.w = cvt_pk_bf16(v1[2], v1[3]); return w; }

struct EpiProj {
    static constexpr bool PERM = false;
    bf16_t* P; const float* rope; float* rmsp;
    __device__ __forceinline__ void operator()(const AccT& acc, const Unit& u, int wr, int wc, int fr, int fq) const {
        const int row0 = u.pm * 256 + wr * 64 + fr;
        const bool lat = u.pm >= 4;
        const bool rms = (u.pn >= 8 && u.pn <= 10);
#pragma unroll
        for (int ai = 0; ai < 2; ++ai)
#pragma unroll
            for (int m = 0; m < 4; ++m) {
                const int R = row0 + ai * 128 + m * 16;
                bf16_t* rowp = P + (size_t)R * LDP + u.pn * 256 + wc * 32 + 4 * fq;
                float ss = 0.f;
#pragma unroll
                for (int bj = 0; bj < 2; ++bj) {
                    const int col32 = u.pn * 256 + bj * 128 + wc * 32;
                    f32x4 v0 = acc[ai][bj][m][0], v1 = acc[ai][bj][m][1];
                    ss += v0[0] * v0[0] + v0[1] * v0[1] + v0[2] * v0[2] + v0[3] * v0[3] + v1[0] * v1[0] + v1[1] * v1[1] + v1[2] * v1[2] + v1[3] * v1[3];
                    if (lat && col32 >= 2816 && col32 < 4160) {
                        const int t = (R - CR) & 2047; const int pos = (wc & 1) ? (t & 63) : (t >> 6);
                        rope4(v0, v1, rope, pos, fq);
                    }
                    *(u32x2*)(rowp + bj * 128) = pack4(v0);
                    *(u32x2*)(rowp + bj * 128 + 16) = pack4(v1);
                }
                if (rms) { ss += __shfl_xor(ss, 16); ss += __shfl_xor(ss, 32); if (fq == 0) rmsp[(size_t)R * 12 + (u.pn - 8) * 4 + wc] = ss; }
            }
    }
};

struct EpiQ {
    static constexpr bool PERM = false;
    bf16_t* Q; const float* rope; const float* rmsp;
    __device__ __forceinline__ void operator()(const AccT& acc, const Unit& u, int wr, int wc, int fr, int fq) const {
        const int row0 = u.pm * 256 + wr * 64 + fr;
        const bool lat = u.pm >= 4;
#pragma unroll
        for (int ai = 0; ai < 2; ++ai)
#pragma unroll
            for (int m = 0; m < 4; ++m) {
                const int R = row0 + ai * 128 + m * 16;
                const f32x4 p0 = *(const f32x4*)(rmsp + (size_t)R * 12), p1 = *(const f32x4*)(rmsp + (size_t)R * 12 + 4);
                const float rs = rsqrtf(((p0[0] + p0[1]) + (p0[2] + p0[3]) + (p1[0] + p1[1]) + (p1[2] + p1[3])) * (1.0f / 512.0f) + 1e-6f);
#pragma unroll
                for (int bj = 0; bj < 2; ++bj) {
                    f32x4 v0 = acc[ai][bj][m][0] * rs, v1 = acc[ai][bj][m][1] * rs;
                    int dcol;
                    if (u.pn < 4) dcol = (2 * u.pn + bj) * 192 + wc * 32 + 4 * fq;
                    else {
                        const int c = bj * 128 + wc * 32;
                        dcol = ((u.pn - 4) * 4 + (c >> 6)) * 192 + 128 + (c & 63) + 4 * fq;
                        if (lat) { const int t = (R - CR) & 2047; const int pos = (wc & 1) ? (t & 63) : (t >> 6); rope4(v0, v1, rope, pos, fq); }
                    }
                    bf16_t* dst = Q + (size_t)R * 1536 + dcol;
                    *(u32x2*)dst = pack4(v0); *(u32x2*)(dst + 16) = pack4(v1);
                }
            }
    }
};

struct EpiKN {
    static constexpr bool PERM = true;
    bf16_t* KN; const float* rmsp;
    __device__ __forceinline__ void operator()(const AccT& acc, const Unit& u, int wr, int wc, int fr, int fq) const {
        const int row0 = u.pm * 256 + wr * 64 + fr;
#pragma unroll
        for (int ai = 0; ai < 2; ++ai)
#pragma unroll
            for (int m = 0; m < 4; ++m) {
                const int R = row0 + ai * 128 + m * 16;
                const f32x4 p = *(const f32x4*)(rmsp + (size_t)R * 12 + 8);
                const float rs = rsqrtf(((p[0] + p[1]) + (p[2] + p[3])) * (1.0f / 256.0f) + 1e-6f);
#pragma unroll
                for (int bj = 0; bj < 2; ++bj)
                    *(u32x4*)(KN + (size_t)R * 1024 + u.pn * 256 + bj * 128 + wc * 32 + 8 * fq) = pack8(acc[ai][bj][m][0] * rs, acc[ai][bj][m][1] * rs);
            }
    }
};

struct EpiVT {
    static constexpr bool PERM = true;
    bf16_t* VT; const float* rmsp;
    __device__ __forceinline__ void operator()(const AccT& acc, const Unit& u, int wr, int wc, int fr, int fq) const {
        const int row0 = u.pm * 256 + wr * 64 + fr;
#pragma unroll
        for (int bj = 0; bj < 2; ++bj) {
            const int tok0 = u.pn * 256 + bj * 128 + wc * 32 + 8 * fq;
            float rs[8];
#pragma unroll
            for (int e = 0; e < 8; ++e) { const f32x4 p = *(const f32x4*)(rmsp + (size_t)(tok0 + e) * 12 + 8); rs[e] = rsqrtf(((p[0] + p[1]) + (p[2] + p[3])) * (1.0f / 256.0f) + 1e-6f); }
#pragma unroll
            for (int ai = 0; ai < 2; ++ai)
#pragma unroll
                for (int m = 0; m < 4; ++m) {
                    const int vr = row0 + ai * 128 + m * 16;
                    f32x4 v0 = acc[ai][bj][m][0], v1 = acc[ai][bj][m][1];
                    v0[0] *= rs[0]; v0[1] *= rs[1]; v0[2] *= rs[2]; v0[3] *= rs[3]; v1[0] *= rs[4]; v1[1] *= rs[5]; v1[2] *= rs[6]; v1[3] *= rs[7];
                    *(u32x4*)(VT + (size_t)vr * MR + tok0) = pack8(v0, v1);
                }
        }
    }
};

struct EpiMerge {
    static constexpr bool PERM = true;
    bf16_t* MB; const bf16_t* P;
    __device__ __forceinline__ void operator()(const AccT& acc, const Unit& u, int wr, int wc, int fr, int fq) const {
        const int row0 = u.pm * 256 + wr * 64 + fr;
#pragma unroll
        for (int ai = 0; ai < 2; ++ai)
#pragma unroll
            for (int m = 0; m < 4; ++m) {
                const int R = row0 + ai * 128 + m * 16;
#pragma unroll
                for (int bj = 0; bj < 2; ++bj) {
                    const int col = u.pn * 256 + bj * 128 + wc * 32 + 8 * fq;
                    const u32x4 gw = *(const u32x4*)(P + (size_t)R * LDP + 4416 + u.z * 2048 + col);
                    f32x4 v0 = acc[ai][bj][m][0], v1 = acc[ai][bj][m][1];
                    v0[0] *= sigmoidf_(bflo(gw.x)); v0[1] *= sigmoidf_(bfhi(gw.x)); v0[2] *= sigmoidf_(bflo(gw.y)); v0[3] *= sigmoidf_(bfhi(gw.y));
                    v1[0] *= sigmoidf_(bflo(gw.z)); v1[1] *= sigmoidf_(bfhi(gw.z)); v1[2] *= sigmoidf_(bflo(gw.w)); v1[3] *= sigmoidf_(bfhi(gw.w));
                    bf16_t* dst = MB + (size_t)R * 2048 + col;
                    if (u.z > 0) { const u32x4 mw = *(const u32x4*)dst;
                        v0[0] += bflo(mw.x); v0[1] += bfhi(mw.x); v0[2] += bflo(mw.y); v0[3] += bfhi(mw.y); v1[0] += bflo(mw.z); v1[1] += bfhi(mw.z); v1[2] += bflo(mw.w); v1[3] += bfhi(mw.w); }
                    *(u32x4*)dst = pack8(v0, v1);
                }
            }
    }
};

struct EpiRes {
    static constexpr bool PERM = false;
    float* XV; const float* gate;
    __device__ __forceinline__ void operator()(const AccT& acc, const Unit& u, int wr, int wc, int fr, int fq) const {
        const int row0 = u.pm * 256 + wr * 64 + fr, col0 = u.pn * 256 + wc * 32 + 4 * fq;
        const float* gp = gate + (size_t)(u.pm < 4 ? 4 : (u.pm - 4) >> 3) * 12288 + col0;
        f32x4 gv[2][2];
#pragma unroll
        for (int bj = 0; bj < 2; ++bj)
#pragma unroll
            for (int n = 0; n < 2; ++n) gv[bj][n] = *(const f32x4*)(gp + bj * 128 + n * 16);
#pragma unroll
        for (int ai = 0; ai < 2; ++ai)
#pragma unroll
            for (int m = 0; m < 4; ++m) { float* rowp = XV + (size_t)(row0 + ai * 128 + m * 16) * 2048 + col0;
#pragma unroll
                for (int bj = 0; bj < 2; ++bj)
#pragma unroll
                    for (int n = 0; n < 2; ++n) { f32x4* p = (f32x4*)(rowp + bj * 128 + n * 16); *p = *p * ALPHA + gv[bj][n] * acc[ai][bj][m][n]; } }
    }
};

struct EpiPartial {
    static constexpr bool PERM = false;
    float* PART;
    __device__ __forceinline__ void operator()(const AccT& acc, const Unit& u, int wr, int wc, int fr, int fq) const {
        const int row0 = u.pm * 256 + wr * 64 + fr, col0 = u.pn * 256 + wc * 32 + 4 * fq;
#pragma unroll
        for (int ai = 0; ai < 2; ++ai)
#pragma unroll
            for (int m = 0; m < 4; ++m) { float* rowp = PART + ((size_t)u.z * CR + row0 + ai * 128 + m * 16) * 2048 + col0;
#pragma unroll
                for (int bj = 0; bj < 2; ++bj)
#pragma unroll
                    for (int n = 0; n < 2; ++n) *(f32x4*)(rowp + bj * 128 + n * 16) = acc[ai][bj][m][n]; }
    }
};

struct EpiSwiglu {
    static constexpr bool PERM = true;
    bf16_t* H;
    __device__ __forceinline__ void operator()(const AccT& acc, const Unit& u, int wr, int wc, int fr, int fq) const {
        const int row0 = u.pm * 256 + wr * 64 + fr;
#pragma unroll
        for (int ai = 0; ai < 2; ++ai)
#pragma unroll
            for (int m = 0; m < 4; ++m) {
                f32x4 o[2];
#pragma unroll
                for (int n = 0; n < 2; ++n)
#pragma unroll
                    for (int j = 0; j < 4; ++j) { const float gt = acc[ai][0][m][n][j]; o[n][j] = gt * sigmoidf_(gt) * acc[ai][1][m][n][j]; }
                *(u32x4*)(H + (size_t)(row0 + ai * 128 + m * 16) * FF + u.pn * 128 + wc * 32 + 8 * fq) = pack8(o[0], o[1]);
            }
    }
};
}

__device__ __forceinline__ int colmap(int kind, int n0, int nsrc) {
    switch (kind) {
        case 0: return n0 < nsrc ? n0 : -1;
        case 1: { const int tile = n0 >> 8, rem = n0 & 255; return (rem >> 7) * FF + tile * 128 + (rem & 127); }
        case 2: if (n0 < 1024) return (n0 >> 7) * 192 + (n0 & 127); else { const int r = n0 - 1024; return (r >> 6) * 192 + 128 + (r & 63); }
        case 3: return (n0 >> 7) * 256 + (n0 & 127);
        default: return (n0 >> 7) * 256 + 128 + (n0 & 127);
    }
}
__device__ __forceinline__ void conv_job(LAS unsigned char* lds, int& tbase, const float* src, int ldsrc, int nsrc, int K, int Np, int kind, const float* kscale, bf16_t* dst, float s_all = 1.0f, int cs_lo = 0, int cs_hi = 0, float s_rng = 1.0f) {
    const int tid = opaque_tid(), wave = tid >> 6, lane = tid & 63;
    LAS bf16_t* T = (LAS bf16_t*)(lds + wave * 8704);
    const int GW = gridDim.x * 8, gw = blockIdx.x * 8 + wave;
    const int tk = K >> 6, ntile = tk * (Np >> 6);
    int first = gw - (tbase % GW); if (first < 0) first += GW;
    for (int t = first; t < ntile; t += GW) {
        const int n0 = (t / tk) << 6, k0 = (t % tk) << 6;
        const int sc = colmap(kind, n0, nsrc);
        f32x4 v[16];
        if (sc >= 0) {
            const float* sp = src + (size_t)(k0 + (lane >> 4)) * ldsrc + sc + (lane & 15) * 4;
#pragma unroll
            for (int r = 0; r < 16; ++r) v[r] = __builtin_nontemporal_load((const f32x4*)(sp + (size_t)(r * 4) * ldsrc));
            const float sf = (n0 >= cs_lo && n0 < cs_hi) ? s_rng : s_all;
            if (kscale) {
#pragma unroll
                for (int r = 0; r < 16; ++r) v[r] = v[r] * (kscale[k0 + r * 4 + (lane >> 4)] * sf);
            } else if (sf != 1.0f) {
#pragma unroll
                for (int r = 0; r < 16; ++r) v[r] = v[r] * sf;
            }
        } else {
#pragma unroll
            for (int r = 0; r < 16; ++r) v[r] = (f32x4){0.f, 0.f, 0.f, 0.f};
        }
        asm volatile("" ::: "memory");
#pragma unroll
        for (int r = 0; r < 16; ++r) *(LAS u32x2*)(T + (r * 4 + (lane >> 4)) * 68 + (lane & 15) * 4) = pg8::pack4(v[r]);
        asm volatile("s_waitcnt lgkmcnt(0)" ::: "memory");
#pragma unroll
        for (int p = 0; p < 8; ++p) {
            const int nr = p * 8 + (lane >> 3), kc = (lane & 7) * 8;
            u32x4 w;
            w.x = (unsigned)T[(kc + 0) * 68 + nr] | ((unsigned)T[(kc + 1) * 68 + nr] << 16); w.y = (unsigned)T[(kc + 2) * 68 + nr] | ((unsigned)T[(kc + 3) * 68 + nr] << 16);
            w.z = (unsigned)T[(kc + 4) * 68 + nr] | ((unsigned)T[(kc + 5) * 68 + nr] << 16); w.w = (unsigned)T[(kc + 6) * 68 + nr] | ((unsigned)T[(kc + 7) * 68 + nr] << 16);
            *(u32x4*)(dst + (size_t)(n0 + nr) * K + k0 + kc) = w;
        }
        asm volatile("s_waitcnt lgkmcnt(0)" ::: "memory");
    }
    tbase += ntile;
}

__device__ __forceinline__ void phase_convert(LAS unsigned char* lds, const Args& a) {
    LAS unsigned char* T = lds;
    int tbase = 0;
#pragma nounroll
    for (int l = 0; l < 2; ++l) {
        unsigned char* wl = a.ws + (size_t)l * W_LAYER;
        conv_job(T, tbase, a.in[6] + (size_t)l * 2048 * INC, INC, INC, 2048, LDP, 0, nullptr, (bf16_t*)(wl + OW_IN), 1.0f, 2880, 3904, 0.125f * LOG2E);
        conv_job(T, tbase, a.in[15] + (size_t)l * 512 * 1536, 1536, 1536, 512, 1536, 2, a.in[14] + l * 512, (bf16_t*)(wl + OW_Q), 0.07216878364870322f * LOG2E);
        conv_job(T, tbase, a.in[17] + (size_t)l * 256 * 2048, 2048, 2048, 256, 1024, 3, a.in[16] + l * 256, (bf16_t*)(wl + OW_K));
        conv_job(T, tbase, a.in[17] + (size_t)l * 256 * 2048, 2048, 2048, 256, 1024, 4, a.in[16] + l * 256, (bf16_t*)(wl + OW_V));
#pragma nounroll
        for (int i = 0; i < 32; ++i) {
            const int d = i >> 4, ri = (i >> 3) & 1, n = i & 7;
            const float* src = (ri ? a.in[11] : a.in[9]) + ((size_t)(l * 2 + d) * 8 + n) * 128 * 128;
            conv_job(T, tbase, src, 128, 128, 128, 128, 0, nullptr, (bf16_t*)(wl + OW_LRU) + (size_t)i * 128 * 128);
        }
#pragma nounroll
        for (int z = 0; z < 3; ++z)
            conv_job(T, tbase, a.in[19] + ((size_t)l * 3 + z) * 1024 * 2048, 2048, 2048, 1024, 2048, 0, nullptr, (bf16_t*)(wl + OW_BR) + (size_t)z * 2048 * 1024);
        conv_job(T, tbase, a.in[20] + (size_t)l * 2048 * 2048, 2048, 2048, 2048, 2048, 0, nullptr, (bf16_t*)(wl + OW_OUT));
        conv_job(T, tbase, a.in[23] + (size_t)l * 2048 * 11264, 11264, 11264, 2048, 11264, 1, nullptr, (bf16_t*)(wl + OW_F1));
        conv_job(T, tbase, a.in[24] + (size_t)l * FF * 2048, 2048, 2048, FF, 2048, 0, nullptr, (bf16_t*)(wl + OW_F2));
    }
    __syncthreads();
}

__device__ __forceinline__ void phase_ada(LAS unsigned char* lds, const Args& a) {
    LAS float* act = (LAS float*)lds;
    LAS float* red = act + 5 * 2048;
    const int tid = opaque_tid(), G = gridDim.x;
    float* ada = (float*)(a.ws + WS_ADA);
    __syncthreads();
    for (int i = tid; i < 5 * 2048; i += NTH) { const int r = i >> 11, k = i & 2047; const float v = r < 4 ? a.in[1][r * 2048 + k] : a.in[3][k]; act[i] = v / (1.0f + __expf(-v)); }
    __syncthreads();
    const int cgp = tid & 7, kg = tid >> 3;
    for (int unit = blockIdx.x; unit < 2 * 384; unit += G) {
        const int l = unit / 384, n0 = (unit % 384) * 32;
        const float* w = a.in[4] + (size_t)l * 2048 * 12288 + n0 + cgp * 4;
        f32x4 acc[5];
#pragma unroll
        for (int r = 0; r < 5; ++r) acc[r] = (f32x4){0.f, 0.f, 0.f, 0.f};
#pragma unroll 8
        for (int kk = 0; kk < 32; ++kk) {
            const int k = kg * 32 + kk;
            const f32x4 wv = __builtin_nontemporal_load((const f32x4*)(w + (size_t)k * 12288));
#pragma unroll
            for (int r = 0; r < 5; ++r) acc[r] += wv * act[r * 2048 + k];
        }
#pragma unroll
        for (int r = 0; r < 5; ++r)
#pragma unroll
            for (int j = 0; j < 4; ++j) red[(kg * 5 + r) * 32 + cgp * 4 + j] = acc[r][j];
        __syncthreads();
        if (tid < 160) { const int r = tid >> 5, col = tid & 31; float s = 0.f;
            for (int q = 0; q < 64; ++q) s += red[(q * 5 + r) * 32 + col];
            ada[(size_t)(l * 5 + r) * 12288 + n0 + col] = s + a.in[5][l * 12288 + n0 + col]; }
        __syncthreads();
    }
}

__device__ __forceinline__ void phase_rope_table(const Args& a) {
    if (blockIdx.x != 0) return;
    float* tab = (float*)(a.ws + WS_ROPE);
    for (int e = threadIdx.x; e < 1024; e += NTH) {
        const int pos = e >> 4, i = e & 15;
        double inv = 1.0; for (int q = 0; q < i; ++q) inv *= 0.56234132519034908;
        const float ang = (float)pos * (float)inv;
        double x = (double)ang;
        const double kq = rint(x * 0.15915494309189535);
        x = (x - kq * 6.283185307179586) - kq * 2.4492935982947064e-16;
        const double x2 = x * x;
        double ts = x, ss = x, tc = 1.0, cs = 1.0;
        for (int q = 1; q <= 15; ++q) { ts *= -x2 / (double)((2 * q) * (2 * q + 1)); ss += ts; tc *= -x2 / (double)((2 * q - 1) * (2 * q)); cs += tc; }
        tab[e * 2] = (float)cs; tab[e * 2 + 1] = (float)ss;
    }
}

__device__ __forceinline__ void phase_init_u(const Args& a) {
    const int tid_ = opaque_tid(); const int lane = tid_ & 63, gw = blockIdx.x * 8 + (tid_ >> 6), nw = gridDim.x * 8;
    float* XV = (float*)(a.ws + WS_XV); bf16_t* U = (bf16_t*)(a.ws + WS_U);
    const float* ada = (const float*)(a.ws + WS_ADA);
    for (int R = gw; R < MR; R += nw) {
        const float* src = R < CR ? a.in[2] + (size_t)R * 2048 : a.in[0] + (size_t)(R - CR) * 2048;
        const float* ar = ada + (size_t)ada_row(R) * 12288;
#pragma unroll
        for (int i = 0; i < 8; ++i) {
            const int c = (i * 64 + lane) * 4;
            const f32x4 v = *(const f32x4*)(src + c);
            *(f32x4*)(XV + (size_t)R * 2048 + c) = v;
            const f32x4 sh = *(const f32x4*)(ar + c), sc = *(const f32x4*)(ar + 2048 + c);
            *(u32x2*)(U + (size_t)R * 2048 + c) = pg8::pack4(v * (sc + 1.0f) + sh);
        }
    }
}

__device__ __forceinline__ void phase_ln(const Args& a, int R0, const float* g, const float* b, const float* mod  , float* out, const float* part = nullptr, int npart = 0, const float* cgate = nullptr) {
    const int tid_ = opaque_tid(); const int lane = tid_ & 63, gw = blockIdx.x * 8 + (tid_ >> 6), nw = gridDim.x * 8;
    float* XV = (float*)(a.ws + WS_XV); bf16_t* U = (bf16_t*)(a.ws + WS_U);
    for (int R = R0 + gw; R < MR; R += nw) {
        f32x4 v[8]; float s = 0.f;
#pragma unroll
        for (int i = 0; i < 8; ++i) v[i] = *(const f32x4*)(XV + (size_t)R * 2048 + (i * 64 + lane) * 4);
        if (npart && R < CR) {
#pragma unroll
            for (int i = 0; i < 8; ++i) {
                const int c = (i * 64 + lane) * 4; f32x4 acc = (f32x4){0.f, 0.f, 0.f, 0.f};
                for (int z = 0; z < npart; ++z) acc += *(const f32x4*)(part + ((size_t)z * CR + R) * 2048 + c);
                v[i] = v[i] * ALPHA + *(const f32x4*)(cgate + c) * acc;
            }
        }
#pragma unroll
        for (int i = 0; i < 8; ++i) s += (v[i][0] + v[i][1]) + (v[i][2] + v[i][3]);
        const float mean = wave_sum(s) * (1.0f / 2048.0f);
        float q = 0.f;
#pragma unroll
        for (int i = 0; i < 8; ++i) { v[i] = v[i] - mean; q += (v[i][0] * v[i][0] + v[i][1] * v[i][1]) + (v[i][2] * v[i][2] + v[i][3] * v[i][3]); }
        const float rstd = rsqrtf(wave_sum(q) * (1.0f / 2048.0f) + 1e-5f);
        const float* ar = mod ? mod + (size_t)ada_row(R) * 12288 : nullptr;
#pragma unroll
        for (int i = 0; i < 8; ++i) {
            const int c = (i * 64 + lane) * 4;
            const f32x4 y = v[i] * rstd * *(const f32x4*)(g + c) + *(const f32x4*)(b + c);
            if (out) { *(f32x4*)(out + (size_t)(R - CR) * 2048 + c) = y; }
            else {
                *(f32x4*)(XV + (size_t)R * 2048 + c) = y;
                const f32x4 sh = *(const f32x4*)(ar + c), sc = *(const f32x4*)(ar + 2048 + c);
                *(u32x2*)(U + (size_t)R * 2048 + c) = pg8::pack4(y * (sc + 1.0f) + sh);
            }
        }
    }
}

__device__ __forceinline__ void phase_svt(LAS unsigned char* lds, const Args& a) {
    LAS bf16_t* T = (LAS bf16_t*)lds;
    const bf16_t* P = (const bf16_t*)(a.ws + WS_PROJ); bf16_t* SVT = (bf16_t*)(a.ws + WS_SVT);
    const int tid = opaque_tid();
    for (int tile = blockIdx.x; tile < MR / 64; tile += gridDim.x) {
        const int R0 = tile * 64;
        __syncthreads();
#pragma unroll
        for (int p = 0; p < 4; ++p) { const int idx = tid + p * NTH, tok = idx >> 5, c8 = (idx & 31) * 8;
            const u32x4 w = *(const u32x4*)(P + (size_t)(R0 + tok) * LDP + 4160 + c8);
            LAS unsigned* d = (LAS unsigned*)(T + tok * 258 + c8); d[0] = w.x; d[1] = w.y; d[2] = w.z; d[3] = w.w; }
        __syncthreads();
#pragma unroll
        for (int p = 0; p < 4; ++p) { const int idx = tid + p * NTH, vr = idx & 255, kc = (idx >> 8) * 8;
            u32x4 w;
            w.x = (unsigned)T[(kc + 0) * 258 + vr] | ((unsigned)T[(kc + 1) * 258 + vr] << 16); w.y = (unsigned)T[(kc + 2) * 258 + vr] | ((unsigned)T[(kc + 3) * 258 + vr] << 16);
            w.z = (unsigned)T[(kc + 4) * 258 + vr] | ((unsigned)T[(kc + 5) * 258 + vr] << 16); w.w = (unsigned)T[(kc + 6) * 258 + vr] | ((unsigned)T[(kc + 7) * 258 + vr] << 16);
            *(u32x4*)(SVT + (size_t)vr * MR + R0 + kc) = w; }
    }
    __syncthreads();
}

template <int DK, int DK1, int DV, bool MASK, int VAR>
__device__ __forceinline__ void attn_unit(LAS unsigned char* lds, const bf16_t* Qp, int ldq, const bf16_t* K1, int ldk1, const bf16_t* K2, int ldk2, const bf16_t* Vt,
                                          int seg0, int n0t, int seg1, int n1t, int qpos0, int kpos1, float m0, float l0, float scale_log2, bf16_t* Op, int ldo) {
    constexpr int KST = DK * 2, KSZ = 64 * KST, VST = 128, VSZ = DV * VST;
    constexpr int NKC = (64 * DK / 8) / NTH, NVC = (DV * 8) / NTH, NKS = DK / 32, NDT = DV / 16;
    const int tid = opaque_tid(), wave = tid >> 6, lane = tid & 63, fr = lane & 15, g = lane >> 4;
    bf16x8 qf[2][NKS];
#pragma unroll
    for (int qs = 0; qs < 2; ++qs)
#pragma unroll
        for (int ks = 0; ks < NKS; ++ks) qf[qs][ks] = *(const bf16x8*)(Qp + (size_t)(wave * 32 + qs * 16 + fr) * ldq + ks * 32 + g * 8);
    f32x4 O[NDT][2];
#pragma unroll
    for (int dt = 0; dt < NDT; ++dt) { O[dt][0] = (f32x4){0.f, 0.f, 0.f, 0.f}; O[dt][1] = (f32x4){0.f, 0.f, 0.f, 0.f}; }
    float mrun[2] = {m0, m0}, lsum[2] = {g == 0 ? l0 : 0.f, g == 0 ? l0 : 0.f};
    const int nt = n0t + n1t;
    const int grp = wave >> 2;
    const int wv = __builtin_amdgcn_readfirstlane(wave);
    constexpr int NKW = KSZ / 1024, KWPW = (NKW + 7) / 8, NVW = VSZ / 1024, VWPW = (NVW + 7) / 8;
    static_assert(KSZ % 8192 == 0 && VSZ % 8192 == 0, "tile images are whole wave-loads, equal per wave");
    int koff[KWPW], voff[VWPW]; unsigned ksel = 0u;
#pragma unroll
    for (int i = 0; i < KWPW; ++i) {
        const int wl = wave + 8 * i, o = wl * 1024 + lane * 16, row = o / KST, pc = (o - row * KST) >> 4, ch = (pc & ~7) + ((pc & 7) ^ ((row >> 1) & 7));
        const int srow = (row & 32) + 8 * ((row >> 2) & 3) + 4 * ((row >> 4) & 1) + (row & 3);
        if (ch < DK1 / 8) koff[i] = srow * ldk1 + ch * 8; else { koff[i] = srow * ldk2 + (ch - DK1 / 8) * 8; ksel |= 1u << i; }
    }
#pragma unroll
    for (int i = 0; i < VWPW; ++i) {
        const int wl = wave + 8 * i, o = wl * 1024 + lane * 16, row = o >> 7, pc = (o & 127) >> 4, ch = pc ^ ((row >> 1) & 7);
        voff[i] = row * MR + ch * 8;
    }
    const int swz = (fr >> 1) & 7, offE = (g ^ swz) * 16, offO = ((4 + g) ^ swz) * 16;
#define ATT_DMA_K(trow, buf) do { const bf16_t* b1_ = K1 + (size_t)(trow) * ldk1; const bf16_t* b2_ = (DK1 < DK) ? K2 + (size_t)(trow) * ldk2 : b1_; \
        _Pragma("unroll") for (int i = 0; i < KWPW; ++i) if (koff[i] >= 0) { const bf16_t* src_ = ((DK1 < DK) && ((ksel >> i) & 1u)) ? b2_ + koff[i] : b1_ + koff[i]; \
            __builtin_amdgcn_global_load_lds((const unsigned*)src_, (LAS unsigned*)(lds + (buf) * KSZ + (wv + 8 * i) * 1024), 16, 0, 0); } } while (0)
#define ATT_DMA_V(trow, buf) do { const bf16_t* bv_ = Vt + (trow); \
        _Pragma("unroll") for (int i = 0; i < VWPW; ++i) if (voff[i] >= 0) \
            __builtin_amdgcn_global_load_lds((const unsigned*)(bv_ + voff[i]), (LAS unsigned*)(lds + 2 * KSZ + (buf) * VSZ + (wv + 8 * i) * 1024), 16, 0, 0); } while (0)
#define ATT_VMWAIT asm volatile("s_waitcnt vmcnt(0)" ::: "memory")
#define ATT_ROW(t) ((t) < n0t ? seg0 + (t) * 64 : seg1 + ((t) - n0t) * 64)
#define ATT_BAR do { asm volatile("s_waitcnt lgkmcnt(0)" ::: "memory"); __builtin_amdgcn_s_barrier(); asm volatile("" ::: "memory"); } while (0)
#define ATT_KLD(dst, i) dst = *(const LAS bf16x8*)(kb + ((i) & 3) * 16 * KST + ((i) >> 3) * 128 + ((((i) >> 2) & 1) ? offO : offE))
#define ATT_X(bufk) do { const LAS unsigned char* kb = lds + (bufk) * KSZ + fr * KST; \
        constexpr int XG = 2, NXG = NKS * 4 / XG;     \
        bf16x8 afr[2][XG]; \
        _Pragma("unroll") for (int q = 0; q < XG; ++q) ATT_KLD(afr[0][q], q); \
        _Pragma("unroll") for (int gi = 0; gi < NXG; ++gi) { \
            if (gi + 1 < NXG) { _Pragma("unroll") for (int q = 0; q < XG; ++q) ATT_KLD(afr[(gi + 1) & 1][q], (gi + 1) * XG + q); } \
            __builtin_amdgcn_sched_barrier(0); \
            _Pragma("unroll") for (int q = 0; q < XG; ++q) { const int i_ = gi * XG + q, kt = i_ & 3, ks = i_ >> 2; \
                s[kt][0] = __builtin_amdgcn_mfma_f32_16x16x32_bf16(afr[gi & 1][q], qf[0][ks], ks == 0 ? (f32x4){0.f, 0.f, 0.f, 0.f} : s[kt][0], 0, 0, 0); \
                s[kt][1] = __builtin_amdgcn_mfma_f32_16x16x32_bf16(afr[gi & 1][q], qf[1][ks], ks == 0 ? (f32x4){0.f, 0.f, 0.f, 0.f} : s[kt][1], 0, 0, 0); } \
            __builtin_amdgcn_sched_barrier(0); } } while (0)
    f32x4 s[4][2];
    bf16x8 pf[2][2];
    __syncthreads();
    ATT_DMA_K(ATT_ROW(0), 0); ATT_DMA_V(ATT_ROW(0), 0); ATT_DMA_K(ATT_ROW(1), 1);
    ATT_VMWAIT;
    __syncthreads();
    if (grp == 1) ATT_BAR;
    ATT_X(0);
    ATT_BAR;
#pragma nounroll
    for (int t = 0; t < nt; ++t) {
        if (grp == 1) { if (t + 2 < nt) ATT_DMA_K(ATT_ROW(t + 2), t & 1); if (t + 1 < nt) ATT_DMA_V(ATT_ROW(t + 1), (t + 1) & 1); }
        const bool masked = MASK && (t >= n0t);
        const int kp0 = kpos1 + (t - n0t) * 64 + g * 8;
#pragma unroll
        for (int qs = 0; qs < 2; ++qs) {
            const int qp = qpos0 + wave * 32 + qs * 16 + fr;
            float mx = -INFINITY;
#pragma unroll
            for (int kt = 0; kt < 4; ++kt)
#pragma unroll
                for (int j = 0; j < 4; ++j) {
                    float v = s[kt][qs][j];
                    if (masked) { const int dlt = kp0 + (kt >> 1) * 32 + (kt & 1) * 4 + j - qp; if (dlt > 128 || dlt < -128) v = -INFINITY; s[kt][qs][j] = v; }
                    mx = fmaxf(mx, v);
                }
            mx = xmax32(xmax16(mx));
            const float mn = fmaxf(mrun[qs], mx);
            const float al = __builtin_amdgcn_exp2f(mrun[qs] - mn);
            mrun[qs] = mn;
#pragma unroll
            for (int dt = 0; dt < NDT; ++dt) O[dt][qs] = O[dt][qs] * al;
            float ps = 0.f;
#pragma unroll
            for (int kt = 0; kt < 4; ++kt)
#pragma unroll
                for (int j = 0; j < 4; ++j) { const float p = __builtin_amdgcn_exp2f(s[kt][qs][j] - mn); s[kt][qs][j] = p; ps += p; }
            lsum[qs] = lsum[qs] * al + ps;
#pragma unroll
            for (int s2 = 0; s2 < 2; ++s2) {
                u32x4 w; w.x = cvt_pk_bf16(s[2 * s2][qs][0], s[2 * s2][qs][1]); w.y = cvt_pk_bf16(s[2 * s2][qs][2], s[2 * s2][qs][3]);
                w.z = cvt_pk_bf16(s[2 * s2 + 1][qs][0], s[2 * s2 + 1][qs][1]); w.w = cvt_pk_bf16(s[2 * s2 + 1][qs][2], s[2 * s2 + 1][qs][3]);
                pf[qs][s2] = __builtin_bit_cast(bf16x8, w);
            }
        }
        if (grp == 0) ATT_VMWAIT;
        ATT_BAR;
        if (grp == 0) { if (t + 2 < nt) ATT_DMA_K(ATT_ROW(t + 2), t & 1); if (t + 1 < nt) ATT_DMA_V(ATT_ROW(t + 1), (t + 1) & 1); }
        {
            const LAS unsigned char* vb = lds + 2 * KSZ + (t & 1) * VSZ + fr * VST;
            constexpr int NIT = 2 * NDT, GSZ = 2, NGR = NIT / GSZ;
            bf16x8 vf[2][GSZ];
#define ATT_VLD(dst, i) dst = *(const LAS bf16x8*)(vb + ((i) % NDT) * 16 * VST + (((i) / NDT) ? offO : offE))
#pragma unroll
            for (int q = 0; q < GSZ; ++q) ATT_VLD(vf[0][q], q);
#pragma unroll
            for (int gi = 0; gi < NGR; ++gi) {
                if (gi + 1 < NGR) {
#pragma unroll
                    for (int q = 0; q < GSZ; ++q) ATT_VLD(vf[(gi + 1) & 1][q], (gi + 1) * GSZ + q);
                }
                __builtin_amdgcn_sched_barrier(0);
#pragma unroll
                for (int q = 0; q < GSZ; ++q) {
                    const int i = gi * GSZ + q, dt = i % NDT, s2 = i / NDT;
                    O[dt][0] = __builtin_amdgcn_mfma_f32_16x16x32_bf16(vf[gi & 1][q], pf[0][s2], O[dt][0], 0, 0, 0);
                    O[dt][1] = __builtin_amdgcn_mfma_f32_16x16x32_bf16(vf[gi & 1][q], pf[1][s2], O[dt][1], 0, 0, 0);
                }
                __builtin_amdgcn_sched_barrier(0);
            }
#undef ATT_VLD
        }
        if (t + 1 < nt) ATT_X((t + 1) & 1);
        if (grp == 1) ATT_VMWAIT;
        ATT_BAR;
    }
    if (grp == 0) ATT_BAR;
#pragma unroll
    for (int qs = 0; qs < 2; ++qs) {
        float l = lsum[qs]; l += __shfl_xor(l, 16); l += __shfl_xor(l, 32);
        const float inv = 1.0f / l;
        bf16_t* orow = Op + (size_t)(wave * 32 + qs * 16 + fr) * ldo + g * 4;
#pragma unroll
        for (int dt = 0; dt < NDT; ++dt) *(u32x2*)(orow + dt * 16) = pg8::pack4(O[dt][qs] * inv);
    }
#undef ATT_DMA_K
#undef ATT_DMA_V
#undef ATT_VMWAIT
#undef ATT_ROW
#undef ATT_BAR
#undef ATT_X
#undef ATT_KLD
}

template <int VAR>
__device__ __forceinline__ void phase_attention(LAS unsigned char* lds, const Args& a, int l, bool need_ctx) {
    const bf16_t* P = (const bf16_t*)(a.ws + WS_PROJ); const bf16_t* QB = (const bf16_t*)(a.ws + WS_QB); const bf16_t* KN = (const bf16_t*)(a.ws + WS_KN);
    const bf16_t* VT = (const bf16_t*)(a.ws + WS_VT); const bf16_t* SVT = (const bf16_t*)(a.ws + WS_SVT); bf16_t* Y = (bf16_t*)(a.ws + (VAR ? WS_END : WS_Y));
    const int G = gridDim.x;
    const int nmla = 256 + (need_ctx ? 32 : 0), nswa = 512 + (need_ctx ? 64 : 0);
    const float mla_sc = 0.07216878364870322f * LOG2E, swa_sc = 0.125f * LOG2E;
    for (int un = blockIdx.x; un < nmla + nswa; un += G) {
        if (VAR == 2 && un >= nmla) continue;
        if (VAR == 3 && un < nmla) continue;
        if (un < nmla) {
            if (un < 256) {
                const int xcd = un & 7, slot = un >> 3, pair = xcd * 4 + (slot >> 3);
                const int b = pair >> 3, h = pair & 7, qb = slot & 7;
                const int qrow = CR + b * SEQ + qb * 256;
                attn_unit<192, 128, 128, false, VAR>(lds, QB + (size_t)qrow * 1536 + h * 192, 1536, KN + h * 128, 1024, P + 2816, LDP, VT + (size_t)h * 128 * MR,
                                                b * CTXL, 4, CR + b * SEQ, 32, 0, 0, -INFINITY, 0.f, mla_sc, Y + (size_t)qrow * 3072 + 1024 + h * 128, 3072);
            } else {
                const int u2 = un - 256, b = u2 >> 3, h = u2 & 7;
                const int qrow = b * CTXL;
                attn_unit<192, 128, 128, false, VAR>(lds, QB + (size_t)qrow * 1536 + h * 192, 1536, KN + h * 128, 1024, P + 2816, LDP, VT + (size_t)h * 128 * MR,
                                                b * CTXL, 4, 0, 0, 0, 0, -INFINITY, 0.f, mla_sc, Y + (size_t)qrow * 3072 + 1024 + h * 128, 3072);
            }
        } else {
            const int us = un - nmla;
            if (us < 512) {
                const int xcd = us & 7, slot = ((us >> 3) & 31) + 32 * (us >> 8), pair = xcd * 2 + (slot >> 5);
                const int b = pair >> 2, gk = pair & 3, h = gk * 4 + ((slot >> 3) & 3), qb = slot & 7;
                const int q0 = qb * 256, qrow = CR + b * SEQ + q0;
                const int ks = q0 >= 128 ? q0 - 128 : 0, ke = q0 + 384 < SEQ ? q0 + 384 : SEQ;
                const float sink = a.in[18][l * 16 + h] * LOG2E;
                attn_unit<64, 64, 64, true, VAR>(lds, P + (size_t)qrow * LDP + 2880 + h * 64, LDP, P + 3904 + gk * 64, LDP, nullptr, 0, SVT + (size_t)gk * 64 * MR,
                                            b * CTXL, 4, CR + b * SEQ + ks, (ke - ks) >> 6, q0, ks, sink, 1.0f, swa_sc, Y + (size_t)qrow * 3072 + 2048 + h * 64, 3072);
            } else {
                const int u2 = us - 512, b = u2 >> 4, h = u2 & 15, gk = h >> 2;
                const int qrow = b * CTXL;
                const float sink = a.in[18][l * 16 + h] * LOG2E;
                attn_unit<64, 64, 64, true, VAR>(lds, P + (size_t)qrow * LDP + 2880 + h * 64, LDP, P + 3904 + gk * 64, LDP, nullptr, 0, SVT + (size_t)gk * 64 * MR,
                                            b * CTXL, 4, 0, 0, 0, 0, sink, 1.0f, swa_sc, Y + (size_t)qrow * 3072 + 2048 + h * 64, 3072);
            }
        }
    }
}

__device__ __forceinline__ float gelu_tanh(float x) {
    const float u2 = 1.5957691216057308f * (x + 0.044715f * x * x * x);
    return x * __builtin_amdgcn_rcpf(1.0f + __builtin_amdgcn_exp2f(-u2 * LOG2E));
}
__device__ __forceinline__ void chunk_info(int ck, int& b, int& cs, int& seqrow0, int& seqlen) {
    if (ck < 16) { b = ck >> 2; cs = ck & 3; seqrow0 = b * CTXL; seqlen = CTXL; } else { const int k2 = ck - 16; b = k2 >> 5; cs = k2 & 31; seqrow0 = CR + b * SEQ; seqlen = SEQ; }
}
__device__ __forceinline__ void lruA_prefetch(const bf16_t* P, int ck, int n, int tid, u32x4 (&raw)[3]) {
    int b, cs, seqrow0, seqlen; chunk_info(ck, b, cs, seqrow0, seqlen);
#pragma unroll
    for (int i = 0; i < 3; ++i) {
        const int idx = tid + i * NTH, rr = idx >> 4, c8 = (idx & 15) * 8, tp = cs * 64 + rr - 2;
        raw[i] = (u32x4){0u, 0u, 0u, 0u};
        if (idx < 67 * 16 && tp >= 0 && tp < seqlen) raw[i] = *(const u32x4*)(P + (size_t)(seqrow0 + tp) * LDP + n * 128 + c8);
    }
}
__device__ __forceinline__ void lruA_unit(LAS unsigned char* lds, const Args& a, int l, int ck, int n, u32x4 (&raw)[3], int nck, int nn, bool has_next) {
    LAS float* Xraw = (LAS float*)lds;
    LAS bf16_t* Xb = (LAS bf16_t*)(lds + 34304);
    LAS float* Ab = (LAS float*)(lds + 51712);
    LAS float* Bb = (LAS float*)(lds + 84480);
    LAS float* SegP = (LAS float*)(lds + 117248); LAS float* SegH = SegP + 512; LAS float* CarP = SegP + 1024; LAS float* CarH = SegP + 1536;
    const bf16_t* P = (const bf16_t*)(a.ws + WS_PROJ);
    bf16_t* HL = (bf16_t*)(a.ws + WS_U); bf16_t* PC = (bf16_t*)(a.ws + WS_MB);
    f32x2* SUM = (f32x2*)(a.ws + WS_SUM);
    const bf16_t* WL = (const bf16_t*)(a.ws + (size_t)l * W_LAYER + OW_LRU);
    const int tid = opaque_tid(), wave = tid >> 6, lane = tid & 63, fr = lane & 15, g = lane >> 4;
    int b, cs, seqrow0, seqlen; chunk_info(ck, b, cs, seqrow0, seqlen);
    const int R0 = seqrow0 + cs * 64;
    __syncthreads();
#pragma unroll
    for (int i = 0; i < 3; ++i) {
        const int idx = tid + i * NTH, rr = idx >> 4, c8 = (idx & 15) * 8;
        if (idx < 67 * 16) { LAS float* d = Xraw + rr * 128 + c8; const u32x4 w = raw[i];
            d[0] = bflo(w.x); d[1] = bfhi(w.x); d[2] = bflo(w.y); d[3] = bfhi(w.y); d[4] = bflo(w.z); d[5] = bfhi(w.z); d[6] = bflo(w.w); d[7] = bfhi(w.w); }
    }
    const int ko = wave * 16 + fr, cch = n * 128 + ko;
    bf16x8 wf[2][2][4];
#pragma unroll
    for (int d = 0; d < 2; ++d)
#pragma unroll
        for (int ri = 0; ri < 2; ++ri)
#pragma unroll
            for (int ks = 0; ks < 4; ++ks) wf[d][ri][ks] = *(const bf16x8*)(WL + ((size_t)((d * 2 + ri) * 8 + n) * 128 + ko) * 128 + ks * 32 + g * 8);
    __syncthreads();
    {
        const int ch = tid & 127, tq = tid >> 7, c2 = n * 128 + ch;
        const float* cw = a.in[7] + (size_t)l * 4 * 1024 + c2;
        const float w0 = cw[0], w1 = cw[1024], w2 = cw[2048], w3 = cw[3072], cb = a.in[8][l * 1024 + c2];
#pragma unroll 4
        for (int i = 0; i < 16; ++i) { const int t = tq * 16 + i;
            const float x = w0 * Xraw[t * 128 + ch] + w1 * Xraw[(t + 1) * 128 + ch] + w2 * Xraw[(t + 2) * 128 + ch] + w3 * Xraw[(t + 3) * 128 + ch] + cb;
            Xb[t * 136 + ch] = (bf16_t)(cvt_pk_bf16(x, 0.f) & 0xffffu); }
    }
    if (has_next) lruA_prefetch(P, nck, nn, tid, raw);
    __syncthreads();
#pragma unroll
    for (int d = 0; d < 2; ++d) {
        {
            f32x4 ar[4], ai[4];
#pragma unroll
            for (int tt = 0; tt < 4; ++tt) { ar[tt] = (f32x4){0.f, 0.f, 0.f, 0.f}; ai[tt] = (f32x4){0.f, 0.f, 0.f, 0.f}; }
#pragma unroll
            for (int ks = 0; ks < 4; ++ks)
#pragma unroll
                for (int tt = 0; tt < 4; ++tt) {
                    const bf16x8 xa = *(const LAS bf16x8*)(Xb + (tt * 16 + fr) * 136 + ks * 32 + g * 8);
                    ar[tt] = __builtin_amdgcn_mfma_f32_16x16x32_bf16(xa, wf[d][0][ks], ar[tt], 0, 0, 0);
                    ai[tt] = __builtin_amdgcn_mfma_f32_16x16x32_bf16(xa, wf[d][1][ks], ai[tt], 0, 0, 0);
                }
            const float biasr = a.in[10][(size_t)(l * 2 + d) * 1024 + cch] * -LOG2E, biasi = a.in[12][(size_t)(l * 2 + d) * 1024 + cch] * -LOG2E;
            const float sp8 = 8.0f * log1pf(__expf(-a.in[13][(size_t)(l * 2 + d) * 1024 + cch]));
#pragma unroll
            for (int tt = 0; tt < 4; ++tt)
#pragma unroll
                for (int j = 0; j < 4; ++j) {
                    const int tok = tt * 16 + g * 4 + j;
                    const float r = __builtin_amdgcn_rcpf(1.0f + __builtin_amdgcn_exp2f(ar[tt][j] * -LOG2E + biasr));
                    const float ig = __builtin_amdgcn_rcpf(1.0f + __builtin_amdgcn_exp2f(ai[tt][j] * -LOG2E + biasi));
                    const float la = -sp8 * r, aa = __builtin_amdgcn_exp2f(la * LOG2E), z = 2.0f * la;
                    const float ser = -z * (1.0f + z * (0.5f + z * (0.16666667f + z * (0.041666668f + z * (0.0083333338f + z * 0.0013888889f)))));
                    const float em = z > -0.25f ? ser : 1.0f - aa * aa;
                    Ab[tok * 128 + ko] = aa; Bb[tok * 128 + ko] = __builtin_amdgcn_sqrtf(em) * ig * bf2f(Xb[tok * 136 + ko]);
                }
        }
        __syncthreads();
        const int seg = tid >> 7, ch = tid & 127;
        {
            float cp = 1.f, h = 0.f;
#pragma unroll 4
            for (int i = 0; i < 16; ++i) { const int t = d ? seg * 16 + 15 - i : seg * 16 + i; const float aa = Ab[t * 128 + ch]; h = aa * h + Bb[t * 128 + ch]; cp *= aa; Ab[t * 128 + ch] = cp; Bb[t * 128 + ch] = h; }
            SegP[seg * 128 + ch] = cp; SegH[seg * 128 + ch] = h;
        }
        __syncthreads();
        {
            float cP = 1.f, cH = 0.f;
            if (d == 0) { for (int s2 = 0; s2 < seg; ++s2) { const float p = SegP[s2 * 128 + ch]; cH = p * cH + SegH[s2 * 128 + ch]; cP *= p; } }
            else { for (int s2 = 3; s2 > seg; --s2) { const float p = SegP[s2 * 128 + ch]; cH = p * cH + SegH[s2 * 128 + ch]; cP *= p; } }
            CarP[seg * 128 + ch] = cP; CarH[seg * 128 + ch] = cH;
            if (seg == (d ? 0 : 3)) { const float p = SegP[seg * 128 + ch]; SUM[((size_t)(d * 144 + ck)) * 1024 + n * 128 + ch] = (f32x2){p * cP, p * cH + SegH[seg * 128 + ch]}; }
        }
        __syncthreads();
#pragma unroll
        for (int p = 0; p < 2; ++p) {
            const int idx = tid + p * NTH, tok = idx >> 4, c8 = (idx & 15) * 8, sg = tok >> 4;
            float hl[8], pc[8];
#pragma unroll
            for (int e = 0; e < 8; ++e) { const float pl = Ab[tok * 128 + c8 + e]; hl[e] = Bb[tok * 128 + c8 + e] + pl * CarH[sg * 128 + c8 + e]; pc[e] = pl * CarP[sg * 128 + c8 + e]; }
            u32x4 wh, wp;
            wh.x = cvt_pk_bf16(hl[0], hl[1]); wh.y = cvt_pk_bf16(hl[2], hl[3]); wh.z = cvt_pk_bf16(hl[4], hl[5]); wh.w = cvt_pk_bf16(hl[6], hl[7]);
            wp.x = cvt_pk_bf16(pc[0], pc[1]); wp.y = cvt_pk_bf16(pc[2], pc[3]); wp.z = cvt_pk_bf16(pc[4], pc[5]); wp.w = cvt_pk_bf16(pc[6], pc[7]);
            const size_t o = ((size_t)d * MR + R0 + tok) * 1024 + n * 128 + c8;
            *(u32x4*)(HL + o) = wh; *(u32x4*)(PC + o) = wp;
        }
        if (d == 0) __syncthreads();
    }
}
__device__ __forceinline__ void phase_lruA(LAS unsigned char* lds, const Args& a, int l) {
    const int G = gridDim.x, nun = 144 * 8, tid = opaque_tid();
    const bf16_t* P = (const bf16_t*)(a.ws + WS_PROJ);
    u32x4 raw[3];
    int un = blockIdx.x;
    if (un < nun) lruA_prefetch(P, un >> 3, un & 7, tid, raw);
    for (; un < nun; un += G) { const int nx = un + G; lruA_unit(lds, a, l, un >> 3, un & 7, raw, nx >> 3, nx & 7, nx < nun); }
    __syncthreads();
}

__device__ __forceinline__ void lruC_unit(LAS unsigned char* lds, const Args& a, int ck, int n) {
    LAS float* Car = (LAS float*)lds;
    const bf16_t* P = (const bf16_t*)(a.ws + WS_PROJ); bf16_t* Y = (bf16_t*)(a.ws + WS_Y);
    const bf16_t* HL = (const bf16_t*)(a.ws + WS_U); const bf16_t* PC = (const bf16_t*)(a.ws + WS_MB);
    const f32x2* SUM = (const f32x2*)(a.ws + WS_SUM);
    const int tid = opaque_tid();
    int b, cs, seqrow0, seqlen; chunk_info(ck, b, cs, seqrow0, seqlen);
    const int R0 = seqrow0 + cs * 64;
    u32x4 h0[2], p0[2], h1[2], p1[2], ag[2];
#pragma unroll
    for (int p = 0; p < 2; ++p) {
        const int idx = tid + p * NTH, tok = idx >> 4, c8 = (idx & 15) * 8;
        const size_t o = ((size_t)R0 + tok) * 1024 + n * 128 + c8;
        h0[p] = *(const u32x4*)(HL + o); p0[p] = *(const u32x4*)(PC + o); h1[p] = *(const u32x4*)(HL + (size_t)MR * 1024 + o); p1[p] = *(const u32x4*)(PC + (size_t)MR * 1024 + o);
        ag[p] = *(const u32x4*)(P + (size_t)(R0 + tok) * LDP + 1024 + n * 128 + c8);
    }
    __syncthreads();
    if (tid < 256) {
        const int d = tid >> 7, ch = tid & 127;
        const bool isctx = ck < 16;
        const int np = d == 0 ? (isctx ? cs : 4 + cs) : (isctx ? 3 - cs : 35 - cs);
        float carry = 0.f;
        for (int j0 = 0; j0 < np; j0 += 12) {
            f32x2 v[12];
#pragma unroll
            for (int q = 0; q < 12; ++q) {
                const int j = j0 + q; int cc;
                if (d == 0) cc = isctx ? b * 4 + j : (j < 4 ? b * 4 + j : 16 + b * 32 + (j - 4));
                else cc = isctx ? b * 4 + 3 - j : (j < 4 ? b * 4 + 3 - j : 16 + b * 32 + 31 - (j - 4));
                v[q] = (f32x2){1.f, 0.f};
                if (j < np) v[q] = SUM[((size_t)(d * 144 + cc)) * 1024 + n * 128 + ch];
            }
#pragma unroll
            for (int q = 0; q < 12; ++q) carry = v[q].x * carry + v[q].y;
        }
        Car[tid] = carry;
    }
    __syncthreads();
#pragma unroll
    for (int p = 0; p < 2; ++p) {
        const int idx = tid + p * NTH, tok = idx >> 4, c8 = (idx & 15) * 8;
        const LAS float* cf = Car + c8; const LAS float* cb = Car + 128 + c8;
        float y[8];
#define LRUC_E(e, hw0, pw0, hw1, pw1, gw, HI) y[e] = ((HI ? bfhi(hw0) : bflo(hw0)) + (HI ? bfhi(pw0) : bflo(pw0)) * cf[e] + (HI ? bfhi(hw1) : bflo(hw1)) + (HI ? bfhi(pw1) : bflo(pw1)) * cb[e]) * gelu_tanh(HI ? bfhi(gw) : bflo(gw))
        LRUC_E(0, h0[p].x, p0[p].x, h1[p].x, p1[p].x, ag[p].x, 0); LRUC_E(1, h0[p].x, p0[p].x, h1[p].x, p1[p].x, ag[p].x, 1);
        LRUC_E(2, h0[p].y, p0[p].y, h1[p].y, p1[p].y, ag[p].y, 0); LRUC_E(3, h0[p].y, p0[p].y, h1[p].y, p1[p].y, ag[p].y, 1);
        LRUC_E(4, h0[p].z, p0[p].z, h1[p].z, p1[p].z, ag[p].z, 0); LRUC_E(5, h0[p].z, p0[p].z, h1[p].z, p1[p].z, ag[p].z, 1);
        LRUC_E(6, h0[p].w, p0[p].w, h1[p].w, p1[p].w, ag[p].w, 0); LRUC_E(7, h0[p].w, p0[p].w, h1[p].w, p1[p].w, ag[p].w, 1);
#undef LRUC_E
        u32x4 w; w.x = cvt_pk_bf16(y[0], y[1]); w.y = cvt_pk_bf16(y[2], y[3]); w.z = cvt_pk_bf16(y[4], y[5]); w.w = cvt_pk_bf16(y[6], y[7]);
        *(u32x4*)(Y + (size_t)(R0 + tok) * 3072 + n * 128 + c8) = w;
    }
}
__device__ __forceinline__ void phase_lruC(LAS unsigned char* lds, const Args& a, int ck0, int skew) {
    const int G = gridDim.x, nun = (144 - ck0) * 8;
    int first = (int)blockIdx.x - (skew % G); if (first < 0) first += G;
    for (int un = first; un < nun; un += G) lruC_unit(lds, a, ck0 + (un >> 3), un & 7);
    __syncthreads();
}

#define XB_TMO      128
#define XB_XCNT(j)  (256  + 64 * (j))
#define XB_XSUB(j)  (1280 + 64 * (j))
#define XB_XGEN(j)  (2304 + 64 * (j))
#define XB_TOP      3328
#define XB_TOPGEN   3392
#define XCD_BAR_WORDS 3456
#define XB_SPIN_CAP (1u << 18)
__device__ __forceinline__ unsigned xb_ld(unsigned* p)              { return __hip_atomic_load(p, __ATOMIC_RELAXED, __HIP_MEMORY_SCOPE_AGENT); }
__device__ __forceinline__ unsigned xb_add(unsigned* p, unsigned v) { return __hip_atomic_fetch_add(p, v, __ATOMIC_RELAXED, __HIP_MEMORY_SCOPE_AGENT); }
__device__ __forceinline__ unsigned xb_xcc_id() { return (unsigned)__builtin_amdgcn_s_getreg((3 << 11) | 20) & 0xFu; }
#define XB_SPIN(cond, bar) do { unsigned _sp = 0; while (cond) { __builtin_amdgcn_s_sleep(1); \
    if ((++_sp & 255u) == 0u) { if (xb_ld(&(bar)[XB_TMO])) break; if (_sp > XB_SPIN_CAP) { atomicAdd(&(bar)[XB_TMO], 1u); break; } } } } while (0)
struct XcdBarrier { unsigned* bar; unsigned x; volatile LAS unsigned* st; };
__device__ __forceinline__ XcdBarrier xcd_barrier_post(unsigned* bar, volatile LAS unsigned* st) {
    XcdBarrier b; b.bar = bar; b.x = xb_xcc_id(); b.st = st;
    if (threadIdx.x == 0) (void)xb_add(&bar[XB_XCNT(b.x)], 1u);
    return b;
}
__device__ __forceinline__ void xcd_barrier_complete(unsigned* bar, unsigned x, unsigned& nloc, unsigned& nx) {
    const unsigned G = gridDim.x * gridDim.y * gridDim.z;
    unsigned sum, cnt, mine, sp = 0u;
    for (;;) {
        sum = 0u; cnt = 0u; mine = 0u;
#pragma unroll
        for (unsigned j = 0; j < 16; ++j) { const unsigned c = xb_ld(&bar[XB_XCNT(j)]); sum += c; cnt += (c > 0u) ? 1u : 0u; mine = (j == x) ? c : mine; }
        if (sum == G) break;
        __builtin_amdgcn_s_sleep(1);
        if ((++sp & 255u) == 0u) { if (xb_ld(&bar[XB_TMO])) break; if (sp > XB_SPIN_CAP) { atomicAdd(&bar[XB_TMO], 1u); break; } }
    }
    nloc = mine > 0u ? mine : 1u; nx = cnt > 0u ? cnt : 1u;
}
__device__ __forceinline__ void xcd_barrier(const XcdBarrier& b) {
    asm volatile("s_waitcnt vmcnt(0)" ::: "memory");
    __syncthreads();
    if (threadIdx.x == 0) {
        unsigned* bar = b.bar;
        __builtin_amdgcn_s_waitcnt(0);
        unsigned nloc = b.st[0], nx = b.st[1];
        if (nloc == 0u) { xcd_barrier_complete(bar, b.x, nloc, nx); b.st[0] = nloc; b.st[1] = nx; }
        const unsigned old = xb_add(&bar[XB_XSUB(b.x)], 1u);
        const unsigned gen = old / nloc;
        if (old + 1u == (gen + 1u) * nloc) {
            __builtin_amdgcn_fence(__ATOMIC_RELEASE, "agent");
            asm volatile("s_waitcnt vmcnt(0)" ::: "memory");
            const unsigned og = xb_add(&bar[XB_TOP], 1u);
            const unsigned tg = og / nx;
            if (og + 1u == (tg + 1u) * nx) xb_add(&bar[XB_TOPGEN], 1u);
            else XB_SPIN(xb_ld(&bar[XB_TOPGEN]) == tg, bar);
            __builtin_amdgcn_fence(__ATOMIC_ACQUIRE, "agent");
            xb_add(&bar[XB_XGEN(b.x)], 1u);
            asm volatile("s_waitcnt vmcnt(0)" ::: "memory");
        } else {
            XB_SPIN(xb_ld(&bar[XB_XGEN(b.x)]) == gen, bar);
            __builtin_amdgcn_fence(__ATOMIC_ACQUIRE, "agent");
            asm volatile("s_waitcnt vmcnt(0)" ::: "memory");
        }
    }
    __syncthreads();
}

__global__ void __launch_bounds__(NTH) mega(Args a) {
    extern __shared__ __attribute__((aligned(16))) unsigned char lds_raw[];
    LAS unsigned char* lds = (LAS unsigned char*)lds_raw;
    cg::grid_group grid = cg::this_grid();
    if (threadIdx.x < 16) ((LAS unsigned*)(lds + 131072))[threadIdx.x] = 0u;
    __syncthreads();
    XcdBarrier xbar = xcd_barrier_post((unsigned*)(a.ws + WS_BAR), (volatile LAS unsigned*)(lds + 131072));
    const int G = gridDim.x, c = blockIdx.x;
    int ph = 0;
#ifndef SUB
#define SUB 0xFF
#endif
#ifndef PHMASK
#define PHMASK 0xFFFF
#endif
#ifndef ATTVAR
#define ATTVAR 2
#endif
#ifndef REPSUB
#define REPSUB 0
#endif
#ifndef REPMASK
#define REPMASK 0
#endif
#define PHASE_BEGIN(id) if ((((PHMASK) >> (id)) & 1) && ph >= a.ph_lo && ph < a.ph_hi) { for (int rep_ = 0; rep_ <= (((REPMASK) >> (id)) & 1); ++rep_) {
#ifndef REPSYNC
#define REPSYNC 0
#endif
#define PHASE_END   } if (ph + 1 < a.ph_hi) { if (a.ph_lo < 0) grid.sync(); for (int rs_ = 0; rs_ <= REPSYNC; ++rs_) xcd_barrier(xbar); } } ++ph;
    unsigned char* ws = a.ws;
    bf16_t* PROJ = (bf16_t*)(ws + WS_PROJ); bf16_t* U = (bf16_t*)(ws + WS_U); bf16_t* Y = (bf16_t*)(ws + WS_Y); bf16_t* QB = (bf16_t*)(ws + WS_QB);
    bf16_t* KN = (bf16_t*)(ws + WS_KN); bf16_t* VT = (bf16_t*)(ws + WS_VT); bf16_t* MB = (bf16_t*)(ws + WS_MB); bf16_t* H = PROJ;
    float* PART4 = (float*)(ws + WS_QB);
    float* PART = (float*)(ws + WS_Y);
    float* XV = (float*)(ws + WS_XV); float* ADA = (float*)(ws + WS_ADA); float* RMS = (float*)(ws + WS_RMS); const float* ROPE = (const float*)(ws + WS_ROPE);

    PHASE_BEGIN(0)
        phase_ada(lds, a); phase_rope_table(a); phase_convert(lds, a);
    PHASE_END
    PHASE_BEGIN(1)
        phase_init_u(a);
    PHASE_END
#pragma nounroll
    for (int l = 0; l < 2; ++l) {
        const bool need_ctx = (l == 0);
        const unsigned char* wl = ws + (size_t)l * W_LAYER;
        const int pm_lo = need_ctx ? 0 : 4, nMl = need_ctx ? 36 : 32;
        PHASE_BEGIN(2)
            pg8::Gemm g{U, (const bf16_t*)(wl + OW_IN), 2048, 2048, 2048, 0, 0};
            pg8::Sched<1> S; S.G = G; S.c = c;
            if (need_ctx) { S.a.init(36, 42, 0, 0); S.b.init(0, 1, 0, 0); } else { S.a.init(32, 42, 4, 0); S.b.init(4, 18, 0, 0); }
            pg8::EpiProj E{PROJ, ROPE, RMS};
            pg8::gemm_phase(lds, g, S, E);
        PHASE_END
        PHASE_BEGIN(3)
            if (SUB & 1) { pg8::Gemm g{PROJ + 2048, (const bf16_t*)(wl + OW_Q), LDP, 512, 512, 0, 0}; pg8::Sched<1> S; S.G = G; S.c = c; S.a.init(nMl, 6, pm_lo, 0); S.b.init(0, 1, 0, 0);
              pg8::EpiQ E{QB, ROPE, RMS}; pg8::gemm_phase(lds, g, S, E); }
            if (SUB & 2) { pg8::Gemm g{PROJ + 2560, (const bf16_t*)(wl + OW_K), LDP, 256, 256, 0, 0}; pg8::Sched<1> S; S.G = G; S.c = (c + 64) % G; S.a.init(36, 4, 0, 0); S.b.init(0, 1, 0, 0);
              pg8::EpiKN E{KN, RMS}; pg8::gemm_phase(lds, g, S, E); }
            if (SUB & 4) { pg8::Gemm g{(const bf16_t*)(wl + OW_V), PROJ + 2560, 256, LDP, 256, 0, 0}; pg8::Sched<1> S; S.G = G; S.c = (c + 128) % G; S.a.init(4, 36, 0, 0); S.b.init(0, 1, 0, 0);
              pg8::EpiVT E{VT, RMS}; pg8::gemm_phase(lds, g, S, E); }
            if (SUB & 8) phase_svt(lds, a);
            for (int r2 = 0; r2 <= ((REPSUB >> 4) & 1); ++r2) phase_lruA(lds, a, l);
        PHASE_END
        PHASE_BEGIN(4)
            phase_attention<0>(lds, a, l, need_ctx); if ((REPSUB >> 5) & 1) phase_attention<ATTVAR>(lds, a, l, need_ctx);
            for (int r2 = 0; r2 <= ((REPSUB >> 6) & 1); ++r2) phase_lruC(lds, a, need_ctx ? 0 : 16, 64);
        PHASE_END
        PHASE_BEGIN(5)
            { pg8::Gemm g{Y, (const bf16_t*)(wl + OW_BR), 3072, 1024, 1024, 1024 * 2, (long)2048 * 1024 * 2};
              pg8::Sched<3> S; S.G = G; S.c = c; S.a.init(32, 8, 4, 0); S.b.init(0, 1, 0, 0);
              pg8::EpiMerge E{MB, PROJ};
              pg8::gemm_phase(lds, g, S, E); }
            if (need_ctx) {
#pragma nounroll
              for (int kh = 0; kh < 2; ++kh) {
                pg8::Gemm g{Y + kh * 512, (const bf16_t*)(wl + OW_BR) + kh * 512, 3072, 1024, 512, 1024 * 2, (long)2048 * 1024 * 2};
                pg8::Sched<3, true> S; S.G = G; S.c = (c + 96 + kh * 128) % G; S.a.init(4, 8, 0, 0); S.b.init(0, 1, 0, 0);
                pg8::EpiPartial E{PART4 + (size_t)kh * 3 * CR * 2048};
                pg8::gemm_phase(lds, g, S, E); }
            }
        PHASE_END
        if (need_ctx) {
        PHASE_BEGIN(11)
            const int tid_ = opaque_tid();
            for (int ch = blockIdx.x * NTH + tid_; ch < CR * 256; ch += G * NTH) {
                const int R = ch >> 8, c8 = (ch & 255) * 8;
                f32x4 m0 = (f32x4){0.f, 0.f, 0.f, 0.f}, m1 = (f32x4){0.f, 0.f, 0.f, 0.f};
#pragma unroll
                for (int br = 0; br < 3; ++br) {
                    const float* p0 = PART4 + ((size_t)br * CR + R) * 2048 + c8; const float* p1 = PART4 + ((size_t)(3 + br) * CR + R) * 2048 + c8;
                    const f32x4 a0 = *(const f32x4*)p0 + *(const f32x4*)p1, a1 = *(const f32x4*)(p0 + 4) + *(const f32x4*)(p1 + 4);
                    const u32x4 gw = *(const u32x4*)(PROJ + (size_t)R * LDP + 4416 + br * 2048 + c8);
                    m0[0] += a0[0] * sigmoidf_(bflo(gw.x)); m0[1] += a0[1] * sigmoidf_(bfhi(gw.x)); m0[2] += a0[2] * sigmoidf_(bflo(gw.y)); m0[3] += a0[3] * sigmoidf_(bfhi(gw.y));
                    m1[0] += a1[0] * sigmoidf_(bflo(gw.z)); m1[1] += a1[1] * sigmoidf_(bfhi(gw.z)); m1[2] += a1[2] * sigmoidf_(bflo(gw.w)); m1[3] += a1[3] * sigmoidf_(bfhi(gw.w));
                }
                *(u32x4*)(MB + (size_t)R * 2048 + c8) = pg8::pack8(m0, m1);
            }
        PHASE_END
        }
        PHASE_BEGIN(6)
            { pg8::Gemm g{MB, (const bf16_t*)(wl + OW_OUT), 2048, 2048, 2048, 0, 0};
              pg8::Sched<1> S; S.G = G; S.c = c; S.a.init(32, 8, 4, 0); S.b.init(0, 1, 0, 0);
              pg8::EpiRes E{XV, ADA + (size_t)l * 5 * 12288 + 4096};
              pg8::gemm_phase(lds, g, S, E); }
            if (need_ctx) {
              pg8::Gemm g{MB, (const bf16_t*)(wl + OW_OUT), 2048, 2048, 256, 256 * 2, 256 * 2};
              pg8::Sched<8, true> S; S.G = G; S.c = c; S.a.init(4, 8, 0, 0); S.b.init(0, 1, 0, 0);
              pg8::EpiPartial E{PART};
              pg8::gemm_phase(lds, g, S, E); }
        PHASE_END
        PHASE_BEGIN(7)
            phase_ln(a, need_ctx ? 0 : CR, a.in[21] + l * 2048, a.in[22] + l * 2048, ADA + (size_t)l * 5 * 12288 + 6144, nullptr, PART, need_ctx ? 8 : 0, ADA + (size_t)(l * 5 + 4) * 12288 + 4096);
        PHASE_END
        PHASE_BEGIN(8)
            pg8::Gemm g{U, (const bf16_t*)(wl + OW_F1), 2048, 2048, 2048, 0, 0};
            pg8::Sched<1> S; S.G = G; S.c = c; S.a.init(nMl, 44, pm_lo, 0); S.b.init(0, 1, 0, 0);
            pg8::EpiSwiglu E{H};
            pg8::gemm_phase(lds, g, S, E);
        PHASE_END
        PHASE_BEGIN(9)
            { pg8::Gemm g{H, (const bf16_t*)(wl + OW_F2), FF, FF, FF, 0, 0};
              pg8::Sched<1> S; S.G = G; S.c = c; S.a.init(32, 8, 4, 0); S.b.init(0, 1, 0, 0);
              pg8::EpiRes E{XV, ADA + (size_t)l * 5 * 12288 + 10240};
              pg8::gemm_phase(lds, g, S, E); }
            if (need_ctx) {
              pg8::Gemm g{H, (const bf16_t*)(wl + OW_F2), FF, FF, 1408, 1408 * 2, 1408 * 2};
              pg8::Sched<4, true> S; S.G = G; S.c = c; S.a.init(4, 8, 0, 0); S.b.init(0, 1, 0, 0);
              pg8::EpiPartial E{PART};
              pg8::gemm_phase(lds, g, S, E); }
        PHASE_END
        PHASE_BEGIN(10)
            if (need_ctx) phase_ln(a, 0, a.in[25] + l * 2048, a.in[26] + l * 2048, ADA + (size_t)(l + 1) * 5 * 12288, nullptr, PART, 4, ADA + (size_t)(l * 5 + 4) * 12288 + 10240);
            else phase_ln(a, CR, a.in[25] + l * 2048, a.in[26] + l * 2048, nullptr, a.out);
        PHASE_END
    }
#undef PHASE_BEGIN
#undef PHASE_END
}

constexpr int N_PHASES = 2 + 2 * 9 + 1;

extern "C" void kernel_launch(void* const* d_in, const int* in_sizes, int n_in, void* d_out, int out_size, void* d_ws, size_t ws_size, hipStream_t stream) {
    static int grid = 0;
    if (grid == 0) {
        if (n_in != 27 || ws_size < WS_END) { fprintf(stderr, "kernel_launch: unexpected n_in %d or ws_size %zu (< %zu)\n", n_in, ws_size, (size_t)WS_END); grid = -1; return; }
        int dev = 0, cus = 0, per_cu = 0;
        hipGetDevice(&dev);
        hipDeviceGetAttribute(&cus, hipDeviceAttributeMultiprocessorCount, dev);
        hipFuncSetAttribute((const void*)mega, hipFuncAttributeMaxDynamicSharedMemorySize, LDS_BYTES);
        hipOccupancyMaxActiveBlocksPerMultiprocessor(&per_cu, (const void*)mega, NTH, LDS_BYTES);
        if (per_cu < 1) per_cu = 1;
        grid = cus * 1;
        (void)hipGetLastError();
    }
    if (grid < 0) return;
    (void)hipMemsetAsync((unsigned char*)d_ws + WS_BAR, 0, 16384, stream);
    Args a{};
    for (int i = 0; i < 27; ++i) a.in[i] = (const float*)d_in[i];
    a.out = (float*)d_out; a.ws = (unsigned char*)d_ws; a.ph_lo = 0; a.ph_hi = N_PHASES;
    void* args[] = {&a};
    hipError_t e = hipLaunchCooperativeKernel((const void*)mega, dim3(grid), dim3(NTH), args, LDS_BYTES, stream);
    if (e != hipSuccess) fprintf(stderr, "cooperative launch failed: %s (grid %d)\n", hipGetErrorString(e), grid);
}
```

```cpp
#include <hip/hip_runtime.h>
#include <hip/hip_cooperative_groups.h>
#include <cstdio>
#include <cstdint>
namespace cg = cooperative_groups;

#define LAS __attribute__((address_space(3)))
typedef unsigned short bf16_t;
typedef short bf16x8 __attribute__((ext_vector_type(8)));
typedef float f32x4 __attribute__((ext_vector_type(4)));
typedef float f32x2 __attribute__((ext_vector_type(2)));
typedef unsigned u32x4 __attribute__((ext_vector_type(4)));
typedef unsigned u32x2 __attribute__((ext_vector_type(2)));

constexpr int DM = 2048, NBATCH = 4, SEQ = 2048, CTXL = 256;
constexpr int CR = NBATCH * CTXL;
constexpr int MR = CR + NBATCH * SEQ;
constexpr int INC = 10560, LDP = 10752;
constexpr int FF = 5632;
constexpr int NTH = 512;
constexpr float ALPHA = 1.41421356237f;
constexpr float LOG2E = 1.44269504089f;

constexpr size_t SZ_WIN = (size_t)LDP * 2048 * 2, SZ_WQ = (size_t)1536 * 512 * 2, SZ_WK = (size_t)1024 * 256 * 2, SZ_WV = SZ_WK;
constexpr size_t SZ_WLRU = (size_t)2 * 2 * 8 * 128 * 128 * 2, SZ_WBR = (size_t)3 * 2048 * 1024 * 2, SZ_WOUT = (size_t)2048 * 2048 * 2;
constexpr size_t SZ_WF1 = (size_t)11264 * 2048 * 2, SZ_WF2 = (size_t)2048 * 5632 * 2;
constexpr size_t OW_IN = 0, OW_Q = OW_IN + SZ_WIN, OW_K = OW_Q + SZ_WQ, OW_V = OW_K + SZ_WK, OW_LRU = OW_V + SZ_WV, OW_BR = OW_LRU + SZ_WLRU,
                 OW_OUT = OW_BR + SZ_WBR, OW_F1 = OW_OUT + SZ_WOUT, OW_F2 = OW_F1 + SZ_WF1, W_LAYER = OW_F2 + SZ_WF2;
constexpr size_t WS_PROJ = 2 * W_LAYER;
constexpr size_t WS_XV = WS_PROJ + (size_t)MR * LDP * 2;
constexpr size_t WS_U = WS_XV + (size_t)MR * 2048 * 4;
constexpr size_t WS_Y = WS_U + (size_t)MR * 2048 * 2;
constexpr size_t WS_QB = WS_Y + (size_t)MR * 3072 * 2;
constexpr size_t WS_KN = WS_QB + (size_t)MR * 1536 * 2;
constexpr size_t WS_VT = WS_KN + (size_t)MR * 1024 * 2;
constexpr size_t WS_SVT = WS_VT + (size_t)MR * 1024 * 2;
constexpr size_t WS_MB = WS_SVT + (size_t)MR * 256 * 2;
constexpr size_t WS_ADA = WS_MB + (size_t)MR * 2048 * 2;
constexpr size_t WS_RMS = WS_ADA + (size_t)2 * 5 * 12288 * 4;
constexpr size_t WS_SUM = WS_RMS + (size_t)MR * 12 * 4;
constexpr size_t WS_ROPE = WS_SUM + (size_t)2 * 144 * 1024 * 8;
constexpr size_t WS_BAR = WS_ROPE + 64 * 16 * 8;
constexpr size_t WS_END = WS_BAR + 16384;

constexpr int LDS_BYTES = 131072 + 64;

struct Args { const float* in[27]; float* out; unsigned char* ws; int ph_lo, ph_hi; };

__device__ __forceinline__ unsigned cvt_pk_bf16(float lo, float hi) { unsigned r; asm volatile("v_cvt_pk_bf16_f32 %0, %1, %2" : "=v"(r) : "v"(lo), "v"(hi)); return r; }
__device__ __forceinline__ float bflo(unsigned w) { return __uint_as_float(w << 16); }
__device__ __forceinline__ float bfhi(unsigned w) { return __uint_as_float(w & 0xffff0000u); }
__device__ __forceinline__ float bf2f(bf16_t v) { return __uint_as_float((unsigned)v << 16); }
__device__ __forceinline__ float sigmoidf_(float x) { return 1.0f / (1.0f + __expf(-x)); }
__device__ __forceinline__ float wave_sum(float v) {
#pragma unroll
    for (int o = 32; o >= 1; o >>= 1) v += __shfl_xor(v, o);
    return v;
}
__device__ __forceinline__ int opaque_tid() { int t = threadIdx.x; asm volatile("" : "+v"(t)); return t; }
__device__ __forceinline__ int ada_row(int R) { return R < CR ? 4 : (R - CR) >> 11; }

namespace pg8 {
constexpr int BM = 256, BK = 64, HALF = 128, HTB = HALF * BK * 2, STAGE_BYTES = 8 * HTB;
__device__ __forceinline__ int lds_byte(int r, int c) { const int st = (r >> 4) * 2 + (c >> 5), rr = r & 15, cc = c & 31, ob = rr * 64 + cc * 2; return st * 1024 + (ob ^ (((ob >> 9) & 1) << 5)); }
__device__ __forceinline__ void stage_rc(int b, int& R, int& C) { const int st = b / 1024, sb = b % 1024, swz = sb ^ (((sb >> 9) & 1) << 5); R = (st >> 1) * 16 + swz / 64; C = (st & 1) * 32 + (swz % 64) / 2; }
__device__ __forceinline__ int perm32(int rho) { const int n = rho >> 4, i = rho & 15; return 8 * (i >> 2) + 4 * n + (i & 3); }

struct Unit { int pm, pn, z; };
struct Gemm { const bf16_t* A; const bf16_t* Bt; int lda, ldb, K; long zA, zB; };

struct Order {
    int nM, nN, pm0, pn0, nwg;
    __device__ __forceinline__ void init(int nM_, int nN_, int pm0_, int pn0_) { nM = nM_; nN = nN_; pm0 = pm0_; pn0 = pn0_; nwg = nM_ * nN_; }
    __device__ __forceinline__ void map(int L, Unit& u) const {
        int wgid = L; { const int q = nwg / 8, r = nwg % 8, xcd = wgid % 8, off = wgid / 8; wgid = (xcd < r ? xcd * (q + 1) : r * (q + 1) + (xcd - r) * q) + off; }
        const int nig = 8 * nN, gid = wgid / nig, fm = gid * 8, gsz = (nM - fm) < 8 ? (nM - fm) : 8;
        u.pm = pm0 + fm + ((wgid % nig) % gsz); u.pn = pn0 + (wgid % nig) / gsz;
    }
};
template <int ZREP, bool ZSPREAD = false> struct Sched {
    Order a, b; int G, c;
    __device__ __forceinline__ bool next(int i, Unit& u) const {
        if (ZSPREAD) { const int L = i * G + c; if (L >= a.nwg * ZREP) return false; const int t = L / ZREP; u.z = L - t * ZREP; a.map(t, u); return true; }
        const int rnd = i / ZREP; u.z = i - rnd * ZREP; int L = rnd * G + c;
        if (L < a.nwg) { a.map(L, u); return true; }
        L -= a.nwg; if (L < b.nwg) { b.map(L, u); return true; }
        return false;
    }
};

template <class Epi, class SchedT>
__device__ __forceinline__ void gemm_phase(LAS unsigned char* lds, const Gemm g, const SchedT& S, const Epi& E) {
    const int tid = opaque_tid(), wid = __builtin_amdgcn_readfirstlane(tid >> 6), lane = tid & 63, wr = wid >> 2, wc = wid & 3, fr = lane & 15, fq = lane >> 4;
    int K = g.K; asm volatile("" : "+s"(K)); const int nt = K / BK;
    unsigned voffA[2], voffB[2];
#pragma unroll
    for (int i = 0; i < 2; ++i) { int R, C; stage_rc(tid * 16 + i * 8192, R, C); const int Rb = Epi::PERM ? ((R & ~31) + perm32(R & 31)) : R;
        voffA[i] = (unsigned)(R * g.lda + C) * 2u; voffB[i] = (unsigned)(Rb * g.ldb + C) * 2u; }
    const size_t kstep = (size_t)(BK * 2);
    const size_t hstepA = (size_t)HALF * g.lda * 2, hstepB = (size_t)HALF * g.ldb * 2;
    const size_t tstepA = 2 * hstepA, tstepB = 2 * hstepB;
    const unsigned ldsw = (unsigned)wid * 1024u;
    const int aoff = lds_byte(wr * 64 + fr, fq * 8), boff = lds_byte(wc * 32 + fr, fq * 8);
#define PG8_SA(b, h) (((b) * 2 + (h)) * HTB)
#define PG8_SB(b, h) ((4 + (b) * 2 + (h)) * HTB)
#define PG8_STAGE(bufoff, gbase, voff) do { _Pragma("unroll") for (int _i = 0; _i < 2; ++_i) \
        __builtin_amdgcn_global_load_lds((const unsigned*)((const char*)(gbase) + (voff)[_i]), (LAS unsigned*)(lds + (bufoff) + ldsw + _i * 8192), 16, 0, 0); } while (0)
#define PG8_LDA(dst, b, h) do { _Pragma("unroll") for (int m = 0; m < 4; ++m) _Pragma("unroll") for (int k = 0; k < 2; ++k) dst[m][k] = *(const LAS bf16x8*)(lds + PG8_SA(b, h) + aoff + m * 2048 + k * 1024); } while (0)
#define PG8_LDB(dst, b, h) do { _Pragma("unroll") for (int n = 0; n < 2; ++n) _Pragma("unroll") for (int k = 0; k < 2; ++k) dst[n][k] = *(const LAS bf16x8*)(lds + PG8_SB(b, h) + boff + n * 2048 + k * 1024); } while (0)
#define PG8_MMA(ai, bj, At, Bt) do { __builtin_amdgcn_s_setprio(1); _Pragma("unroll") for (int m = 0; m < 4; ++m) _Pragma("unroll") for (int n = 0; n < 2; ++n) _Pragma("unroll") for (int k = 0; k < 2; ++k) \
        acc[ai][bj][m][n] = __builtin_amdgcn_mfma_f32_16x16x32_bf16(Bt[n][k], At[m][k], acc[ai][bj][m][n], 0, 0, 0); __builtin_amdgcn_s_setprio(0); } while (0)
#define PG8_WAIT_V(n) asm volatile("s_waitcnt vmcnt(" #n ")" ::: "memory")
#define PG8_WAIT_L(n) asm volatile("s_waitcnt lgkmcnt(" #n ")" ::: "memory")
#define PG8_BAR __builtin_amdgcn_s_barrier()
#define PG8_SCHED __builtin_amdgcn_sched_barrier(0)
    Unit cur, nxt; int ui = 0;
    if (!S.next(0, cur)) return;
    f32x4 acc[2][2][4][2];
#pragma unroll
    for (int a = 0; a < 2; ++a)
#pragma unroll
        for (int b = 0; b < 2; ++b)
#pragma unroll
            for (int m = 0; m < 4; ++m)
#pragma unroll
                for (int n = 0; n < 2; ++n) acc[a][b][m][n] = (f32x4){0.f, 0.f, 0.f, 0.f};
    bf16x8 At[4][2], B0[2][2], B1[2][2];
    const char* cA = (const char*)g.A + (long)cur.z * g.zA + (size_t)cur.pm * tstepA; const char* cB = (const char*)g.Bt + (long)cur.z * g.zB + (size_t)cur.pn * tstepB;
    PG8_STAGE(PG8_SB(0, 0), cB, voffB); PG8_STAGE(PG8_SB(0, 1), cB + hstepB, voffB); PG8_STAGE(PG8_SA(0, 0), cA, voffA); PG8_STAGE(PG8_SA(0, 1), cA + hstepA, voffA);
    if (wr == 1) PG8_BAR;
    PG8_WAIT_V(2); PG8_BAR;
    PG8_STAGE(PG8_SB(1, 0), cB + kstep, voffB); PG8_STAGE(PG8_SA(1, 0), cA + kstep, voffA); PG8_STAGE(PG8_SB(1, 1), cB + hstepB + kstep, voffB);
    PG8_WAIT_V(6); PG8_BAR;
    for (;;) {
        const bool has_next = S.next(ui + 1, nxt);
        const char* nA = has_next ? (const char*)g.A + (long)nxt.z * g.zA + (size_t)nxt.pm * tstepA : cA; const char* nB = has_next ? (const char*)g.Bt + (long)nxt.z * g.zB + (size_t)nxt.pn * tstepB : cB;
        for (int t = 0; t < nt; t += 2) {
            const bool last = (t == nt - 2);
            const char* a1 = cA + (size_t)(t + 1) * kstep;
            const char* a2 = last ? nA : cA + (size_t)(t + 2) * kstep; const char* b2 = last ? nB : cB + (size_t)(t + 2) * kstep;
            const char* a3 = a2 + kstep; const char* b3 = b2 + kstep;
            PG8_LDB(B0, 0, 0); PG8_LDB(B1, 0, 1); PG8_SCHED; PG8_LDA(At, 0, 0); PG8_STAGE(PG8_SA(1, 1), a1 + hstepA, voffA);
            PG8_WAIT_V(8); PG8_WAIT_L(0); PG8_BAR; PG8_MMA(0, 0, At, B0); PG8_MMA(0, 1, At, B1); PG8_BAR; PG8_SCHED;
            PG8_LDA(At, 0, 1); PG8_STAGE(PG8_SB(0, 0), b2, voffB); PG8_STAGE(PG8_SB(0, 1), b2 + hstepB, voffB); PG8_STAGE(PG8_SA(0, 0), a2, voffA);
            PG8_WAIT_V(8); PG8_WAIT_L(0); PG8_BAR; PG8_MMA(1, 0, At, B0); PG8_MMA(1, 1, At, B1); PG8_BAR; PG8_SCHED;
            PG8_LDB(B0, 1, 0); PG8_LDB(B1, 1, 1); PG8_SCHED; PG8_LDA(At, 1, 0); PG8_STAGE(PG8_SA(0, 1), a2 + hstepA, voffA);
            PG8_WAIT_V(8); PG8_WAIT_L(0); PG8_BAR; PG8_MMA(0, 0, At, B0); PG8_MMA(0, 1, At, B1); PG8_BAR; PG8_SCHED;
            PG8_LDA(At, 1, 1); PG8_STAGE(PG8_SB(1, 0), b3, voffB); PG8_STAGE(PG8_SB(1, 1), b3 + hstepB, voffB); PG8_STAGE(PG8_SA(1, 0), a3, voffA);
            PG8_WAIT_V(8); PG8_WAIT_L(0); PG8_BAR; PG8_MMA(1, 0, At, B0); PG8_MMA(1, 1, At, B1); PG8_BAR; PG8_SCHED;
        }
        if (wr == 0) PG8_BAR;
        E(acc, cur, wr, wc, fr, fq);
        if (!has_next) break;
#pragma unroll
        for (int a = 0; a < 2; ++a)
#pragma unroll
            for (int b = 0; b < 2; ++b)
#pragma unroll
                for (int m = 0; m < 4; ++m)
#pragma unroll
                    for (int n = 0; n < 2; ++n) acc[a][b][m][n] = (f32x4){0.f, 0.f, 0.f, 0.f};
        cur = nxt; cA = nA; cB = nB; ++ui;
        if (wr == 1) PG8_BAR;
    }
    PG8_WAIT_V(0);
    PG8_BAR;
#undef PG8_SA
#undef PG8_SB
#undef PG8_STAGE
#undef PG8_LDA
#undef PG8_LDB
#undef PG8_MMA
#undef PG8_WAIT_V
#undef PG8_WAIT_L
#undef PG8_BAR
#undef PG8_SCHED
}

typedef f32x4 AccT[2][2][4][2];

__device__ __forceinline__ void rope4(f32x4& v0, f32x4& v1, const float* rope, int pos, int fq) {
    const f32x4* rp = (const f32x4*)(rope + (pos * 16 + 4 * fq) * 2);
    const f32x4 c01 = rp[0], c23 = rp[1];
    f32x4 a = v0, b = v1;
    v0[0] = a[0] * c01[0] - b[0] * c01[1]; v1[0] = a[0] * c01[1] + b[0] * c01[0];
    v0[1] = a[1] * c01[2] - b[1] * c01[3]; v1[1] = a[1] * c01[3] + b[1] * c01[2];
    v0[2] = a[2] * c23[0] - b[2] * c23[1]; v1[2] = a[2] * c23[1] + b[2] * c23[0];
    v0[3] = a[3] * c23[2] - b[3] * c23[3]; v1[3] = a[3] * c23[3] + b[3] * c23[2];
}
__device__ __forceinline__ u32x2 pack4(f32x4 v) { u32x2 w; w.x = cvt_pk_bf16(v[0], v[1]); w.y = cvt_pk_bf16(v[2], v[3]); return w; }
__device__ __forceinline__ u32x4 pack8(f32x4 v0, f32x4 v1) { u32x4 w; w.x = cvt_pk_bf16(v0[0], v0[1]); w.y = cvt_pk_bf16(v0[2], v0[3]); w.z = cvt_pk_bf16(v1[0], v1[1]); w.w = cvt_pk_bf16(v1[2], v1[3]); return w; }

struct EpiProj {
    static constexpr bool PERM = false;
    bf16_t* P; const float* rope; float* rmsp;
    __device__ __forceinline__ void operator()(const AccT& acc, const Unit& u, int wr, int wc, int fr, int fq) const {
        const int row0 = u.pm * 256 + wr * 64 + fr;
        const bool lat = u.pm >= 4;
        const bool rms = (u.pn >= 8 && u.pn <= 10);
#pragma unroll
        for (int ai = 0; ai < 2; ++ai)
#pragma unroll
            for (int m = 0; m < 4; ++m) {
                const int R = row0 + ai * 128 + m * 16;
                bf16_t* rowp = P + (size_t)R * LDP + u.pn * 256 + wc * 32 + 4 * fq;
                float ss = 0.f;
#pragma unroll
                for (int bj = 0; bj < 2; ++bj) {
                    const int col32 = u.pn * 256 + bj * 128 + wc * 32;
                    f32x4 v0 = acc[ai][bj][m][0], v1 = acc[ai][bj][m][1];
                    ss += v0[0] * v0[0] + v0[1] * v0[1] + v0[2] * v0[2] + v0[3] * v0[3] + v1[0] * v1[0] + v1[1] * v1[1] + v1[2] * v1[2] + v1[3] * v1[3];
                    if (lat && col32 >= 2816 && col32 < 4160) {
                        const int t = (R - CR) & 2047; const int pos = (wc & 1) ? (t & 63) : (t >> 6);
                        rope4(v0, v1, rope, pos, fq);
                    }
                    *(u32x2*)(rowp + bj * 128) = pack4(v0);
                    *(u32x2*)(rowp + bj * 128 + 16) = pack4(v1);
                }
                if (rms) { ss += __shfl_xor(ss, 16); ss += __shfl_xor(ss, 32); if (fq == 0) rmsp[(size_t)R * 12 + (u.pn - 8) * 4 + wc] = ss; }
            }
    }
};

struct EpiQ {
    static constexpr bool PERM = false;
    bf16_t* Q; const float* rope; const float* rmsp;
    __device__ __forceinline__ void operator()(const AccT& acc, const Unit& u, int wr, int wc, int fr, int fq) const {
        const int row0 = u.pm * 256 + wr * 64 + fr;
        const bool lat = u.pm >= 4;
#pragma unroll
        for (int ai = 0; ai < 2; ++ai)
#pragma unroll
            for (int m = 0; m < 4; ++m) {
                const int R = row0 + ai * 128 + m * 16;
                const f32x4 p0 = *(const f32x4*)(rmsp + (size_t)R * 12), p1 = *(const f32x4*)(rmsp + (size_t)R * 12 + 4);
                const float rs = rsqrtf(((p0[0] + p0[1]) + (p0[2] + p0[3]) + (p1[0] + p1[1]) + (p1[2] + p1[3])) * (1.0f / 512.0f) + 1e-6f);
#pragma unroll
                for (int bj = 0; bj < 2; ++bj) {
                    f32x4 v0 = acc[ai][bj][m][0] * rs, v1 = acc[ai][bj][m][1] * rs;
                    int dcol;
                    if (u.pn < 4) dcol = (2 * u.pn + bj) * 192 + wc * 32 + 4 * fq;
                    else {
                        const int c = bj * 128 + wc * 32;
                        dcol = ((u.pn - 4) * 4 + (c >> 6)) * 192 + 128 + (c & 63) + 4 * fq;
                        if (lat) { const int t = (R - CR) & 2047; const int pos = (wc & 1) ? (t & 63) : (t >> 6); rope4(v0, v1, rope, pos, fq); }
                    }
                    bf16_t* dst = Q + (size_t)R * 1536 + dcol;
                    *(u32x2*)dst = pack4(v0); *(u32x2*)(dst + 16) = pack4(v1);
                }
            }
    }
};

struct EpiKN {
    static constexpr bool PERM = true;
    bf16_t* KN; const float* rmsp;
    __device__ __forceinline__ void operator()(const AccT& acc, const Unit& u, int wr, int wc, int fr, int fq) const {
        const int row0 = u.pm * 256 + wr * 64 + fr;
#pragma unroll
        for (int ai = 0; ai < 2; ++ai)
#pragma unroll
            for (int m = 0; m < 4; ++m) {
                const int R = row0 + ai * 128 + m * 16;
                const f32x4 p = *(const f32x4*)(rmsp + (size_t)R * 12 + 8);
                const float rs = rsqrtf(((p[0] + p[1]) + (p[2] + p[3])) * (1.0f / 256.0f) + 1e-6f);
#pragma unroll
                for (int bj = 0; bj < 2; ++bj)
                    *(u32x4*)(KN + (size_t)R * 1024 + u.pn * 256 + bj * 128 + wc * 32 + 8 * fq) = pack8(acc[ai][bj][m][0] * rs, acc[ai][bj][m][1] * rs);
            }
    }
};

struct EpiVT {
    static constexpr bool PERM = true;
    bf16_t* VT; const float* rmsp;
    __device__ __forceinline__ void operator()(const AccT& acc, const Unit& u, int wr, int wc, int fr, int fq) const {
        const int row0 = u.pm * 256 + wr * 64 + fr;
#pragma unroll
        for (int bj = 0; bj < 2; ++bj) {
            const int tok0 = u.pn * 256 + bj * 128 + wc * 32 + 8 * fq;
            float rs[8];
#pragma unroll
            for (int e = 0; e < 8; ++e) { const f32x4 p = *(const f32x4*)(rmsp + (size_t)(tok0 + e) * 12 + 8); rs[e] = rsqrtf(((p[0] + p[1]) + (p[2] + p[3])) * (1.0f / 256.0f) + 1e-6f); }
#pragma unroll
            for (int ai = 0; ai < 2; ++ai)
#pragma unroll
                for (int m = 0; m < 4; ++m) {
                    const int vr = row0 + ai * 128 + m * 16;
                    f32x4 v0 = acc[ai][bj][m][0], v1 = acc[ai][bj][m][1];
                    v0[0] *= rs[0]; v0[1] *= rs[1]; v0[2] *= rs[2]; v0[3] *= rs[3]; v1[0] *= rs[4]; v1[1] *= rs[5]; v1[2] *= rs[6]; v1[3] *= rs[7];
                    *(u32x4*)(VT + (size_t)vr * MR + tok0) = pack8(v0, v1);
                }
        }
    }
};

struct EpiMerge {
    static constexpr bool PERM = true;
    bf16_t* MB; const bf16_t* P;
    __device__ __forceinline__ void operator()(const AccT& acc, const Unit& u, int wr, int wc, int fr, int fq) const {
        const int row0 = u.pm * 256 + wr * 64 + fr;
#pragma unroll
        for (int ai = 0; ai < 2; ++ai)
#pragma unroll
            for (int m = 0; m < 4; ++m) {
                const int R = row0 + ai * 128 + m * 16;
#pragma unroll
                for (int bj = 0; bj < 2; ++bj) {
                    const int col = u.pn * 256 + bj * 128 + wc * 32 + 8 * fq;
                    const u32x4 gw = *(const u32x4*)(P + (size_t)R * LDP + 4416 + u.z * 2048 + col);
                    f32x4 v0 = acc[ai][bj][m][0], v1 = acc[ai][bj][m][1];
                    v0[0] *= sigmoidf_(bflo(gw.x)); v0[1] *= sigmoidf_(bfhi(gw.x)); v0[2] *= sigmoidf_(bflo(gw.y)); v0[3] *= sigmoidf_(bfhi(gw.y));
                    v1[0] *= sigmoidf_(bflo(gw.z)); v1[1] *= sigmoidf_(bfhi(gw.z)); v1[2] *= sigmoidf_(bflo(gw.w)); v1[3] *= sigmoidf_(bfhi(gw.w));
                    bf16_t* dst = MB + (size_t)R * 2048 + col;
                    if (u.z > 0) { const u32x4 mw = *(const u32x4*)dst;
                        v0[0] += bflo(mw.x); v0[1] += bfhi(mw.x); v0[2] += bflo(mw.y); v0[3] += bfhi(mw.y); v1[0] += bflo(mw.z); v1[1] += bfhi(mw.z); v1[2] += bflo(mw.w); v1[3] += bfhi(mw.w); }
                    *(u32x4*)dst = pack8(v0, v1);
                }
            }
    }
};

struct EpiRes {
    static constexpr bool PERM = false;
    float* XV; const float* gate;
    __device__ __forceinline__ void operator()(const AccT& acc, const Unit& u, int wr, int wc, int fr, int fq) const {
        const int row0 = u.pm * 256 + wr * 64 + fr, col0 = u.pn * 256 + wc * 32 + 4 * fq;
        const float* gp = gate + (size_t)(u.pm < 4 ? 4 : (u.pm - 4) >> 3) * 12288 + col0;
        f32x4 gv[2][2];
#pragma unroll
        for (int bj = 0; bj < 2; ++bj)
#pragma unroll
            for (int n = 0; n < 2; ++n) gv[bj][n] = *(const f32x4*)(gp + bj * 128 + n * 16);
#pragma unroll
        for (int ai = 0; ai < 2; ++ai)
#pragma unroll
            for (int m = 0; m < 4; ++m) { float* rowp = XV + (size_t)(row0 + ai * 128 + m * 16) * 2048 + col0;
#pragma unroll
                for (int bj = 0; bj < 2; ++bj)
#pragma unroll
                    for (int n = 0; n < 2; ++n) { f32x4* p = (f32x4*)(rowp + bj * 128 + n * 16); *p = *p * ALPHA + gv[bj][n] * acc[ai][bj][m][n]; } }
    }
};

struct EpiPartial {
    static constexpr bool PERM = false;
    float* PART;
    __device__ __forceinline__ void operator()(const AccT& acc, const Unit& u, int wr, int wc, int fr, int fq) const {
        const int row0 = u.pm * 256 + wr * 64 + fr, col0 = u.pn * 256 + wc * 32 + 4 * fq;
#pragma unroll
        for (int ai = 0; ai < 2; ++ai)
#pragma unroll
            for (int m = 0; m < 4; ++m) { float* rowp = PART + ((size_t)u.z * CR + row0 + ai * 128 + m * 16) * 2048 + col0;
#pragma unroll
                for (int bj = 0; bj < 2; ++bj)
#pragma unroll
                    for (int n = 0; n < 2; ++n) *(f32x4*)(rowp + bj * 128 + n * 16) = acc[ai][bj][m][n]; }
    }
};

struct EpiSwiglu {
    static constexpr bool PERM = true;
    bf16_t* H;
    __device__ __forceinline__ void operator()(const AccT& acc, const Unit& u, int wr, int wc, int fr, int fq) const {
        const int row0 = u.pm * 256 + wr * 64 + fr;
#pragma unroll
        for (int ai = 0; ai < 2; ++ai)
#pragma unroll
            for (int m = 0; m < 4; ++m) {
                f32x4 o[2];
#pragma unroll
                for (int n = 0; n < 2; ++n)
#pragma unroll
                    for (int j = 0; j < 4; ++j) { const float gt = acc[ai][0][m][n][j]; o[n][j] = gt * sigmoidf_(gt) * acc[ai][1][m][n][j]; }
                *(u32x4*)(H + (size_t)(row0 + ai * 128 + m * 16) * FF + u.pn * 128 + wc * 32 + 8 * fq) = pack8(o[0], o[1]);
            }
    }
};
}

__device__ __forceinline__ int colmap(int kind, int n0, int nsrc) {
    switch (kind) {
        case 0: return n0 < nsrc ? n0 : -1;
        case 1: { const int tile = n0 >> 8, rem = n0 & 255; return (rem >> 7) * FF + tile * 128 + (rem & 127); }
        case 2: if (n0 < 1024) return (n0 >> 7) * 192 + (n0 & 127); else { const int r = n0 - 1024; return (r >> 6) * 192 + 128 + (r & 63); }
        case 3: return (n0 >> 7) * 256 + (n0 & 127);
        default: return (n0 >> 7) * 256 + 128 + (n0 & 127);
    }
}
__device__ __forceinline__ void conv_job(LAS unsigned char* lds, int& tbase, const float* src, int ldsrc, int nsrc, int K, int Np, int kind, const float* kscale, bf16_t* dst, float s_all = 1.0f, int cs_lo = 0, int cs_hi = 0, float s_rng = 1.0f) {
    const int tid = opaque_tid(), wave = tid >> 6, lane = tid & 63;
    LAS bf16_t* T = (LAS bf16_t*)(lds + wave * 8704);
    const int GW = gridDim.x * 8, gw = blockIdx.x * 8 + wave;
    const int tk = K >> 6, ntile = tk * (Np >> 6);
    int first = gw - (tbase % GW); if (first < 0) first += GW;
    for (int t = first; t < ntile; t += GW) {
        const int n0 = (t / tk) << 6, k0 = (t % tk) << 6;
        const int sc = colmap(kind, n0, nsrc);
        f32x4 v[16];
        if (sc >= 0) {
            const float* sp = src + (size_t)(k0 + (lane >> 4)) * ldsrc + sc + (lane & 15) * 4;
#pragma unroll
            for (int r = 0; r < 16; ++r) v[r] = __builtin_nontemporal_load((const f32x4*)(sp + (size_t)(r * 4) * ldsrc));
            const float sf = (n0 >= cs_lo && n0 < cs_hi) ? s_rng : s_all;
            if (kscale) {
#pragma unroll
                for (int r = 0; r < 16; ++r) v[r] = v[r] * (kscale[k0 + r * 4 + (lane >> 4)] * sf);
            } else if (sf != 1.0f) {
#pragma unroll
                for (int r = 0; r < 16; ++r) v[r] = v[r] * sf;
            }
        } else {
#pragma unroll
            for (int r = 0; r < 16; ++r) v[r] = (f32x4){0.f, 0.f, 0.f, 0.f};
        }
        asm volatile("" ::: "memory");
#pragma unroll
        for (int r = 0; r < 16; ++r) *(LAS u32x2*)(T + (r * 4 + (lane >> 4)) * 68 + (lane & 15) * 4) = pg8::pack4(v[r]);
        asm volatile("s_waitcnt lgkmcnt(0)" ::: "memory");
#pragma unroll
        for (int p = 0; p < 8; ++p) {
            const int nr = p * 8 + (lane >> 3), kc = (lane & 7) * 8;
            u32x4 w;
            w.x = (unsigned)T[(kc + 0) * 68 + nr] | ((unsigned)T[(kc + 1) * 68 + nr] << 16); w.y = (unsigned)T[(kc + 2) * 68 + nr] | ((unsigned)T[(kc + 3) * 68 + nr] << 16);
            w.z = (unsigned)T[(kc + 4) * 68 + nr] | ((unsigned)T[(kc + 5) * 68 + nr] << 16); w.w = (unsigned)T[(kc + 6) * 68 + nr] | ((unsigned)T[(kc + 7) * 68 + nr] << 16);
            *(u32x4*)(dst + (size_t)(n0 + nr) * K + k0 + kc) = w;
        }
        asm volatile("s_waitcnt lgkmcnt(0)" ::: "memory");
    }
    tbase += ntile;
}

__device__ __forceinline__ void phase_convert(LAS unsigned char* lds, const Args& a) {
    LAS unsigned char* T = lds;
    int tbase = 0;
#pragma nounroll
    for (int l = 0; l < 2; ++l) {
        unsigned char* wl = a.ws + (size_t)l * W_LAYER;
        conv_job(T, tbase, a.in[6] + (size_t)l * 2048 * INC, INC, INC, 2048, LDP, 0, nullptr, (bf16_t*)(wl + OW_IN), 1.0f, 2880, 3904, 0.125f * LOG2E);
        conv_job(T, tbase, a.in[15] + (size_t)l * 512 * 1536, 1536, 1536, 512, 1536, 2, a.in[14] + l * 512, (bf16_t*)(wl + OW_Q), 0.07216878364870322f * LOG2E);
        conv_job(T, tbase, a.in[17] + (size_t)l * 256 * 2048, 2048, 2048, 256, 1024, 3, a.in[16] + l * 256, (bf16_t*)(wl + OW_K));
        conv_job(T, tbase, a.in[17] + (size_t)l * 256 * 2048, 2048, 2048, 256, 1024, 4, a.in[16] + l * 256, (bf16_t*)(wl + OW_V));
#pragma nounroll
        for (int i = 0; i < 32; ++i) {
            const int d = i >> 4, ri = (i >> 3) & 1, n = i & 7;
            const float* src = (ri ? a.in[11] : a.in[9]) + ((size_t)(l * 2 + d) * 8 + n) * 128 * 128;
            conv_job(T, tbase, src, 128, 128, 128, 128, 0, nullptr, (bf16_t*)(wl + OW_LRU) + (size_t)i * 128 * 128);
        }
#pragma nounroll
        for (int z = 0; z < 3; ++z)
            conv_job(T, tbase, a.in[19] + ((size_t)l * 3 + z) * 1024 * 2048, 2048, 2048, 1024, 2048, 0, nullptr, (bf16_t*)(wl + OW_BR) + (size_t)z * 2048 * 1024);
        conv_job(T, tbase, a.in[20] + (size_t)l * 2048 * 2048, 2048, 2048, 2048, 2048, 0, nullptr, (bf16_t*)(wl + OW_OUT));
        conv_job(T, tbase, a.in[23] + (size_t)l * 2048 * 11264, 11264, 11264, 2048, 11264, 1, nullptr, (bf16_t*)(wl + OW_F1));
        conv_job(T, tbase, a.in[24] + (size_t)l * FF * 2048, 2048, 2048, FF, 2048, 0, nullptr, (bf16_t*)(wl + OW_F2));
    }
    __syncthreads();
}

__device__ __forceinline__ void phase_ada(LAS unsigned char* lds, const Args& a) {
    LAS float* act = (LAS float*)lds;
    LAS float* red = act + 5 * 2048;
    const int tid = opaque_tid(), G = gridDim.x;
    float* ada = (float*)(a.ws + WS_ADA);
    __syncthreads();
    for (int i = tid; i < 5 * 2048; i += NTH) { const int r = i >> 11, k = i & 2047; const float v = r < 4 ? a.in[1][r * 2048 + k] : a.in[3][k]; act[i] = v / (1.0f + __expf(-v)); }
    __syncthreads();
    const int cgp = tid & 7, kg = tid >> 3;
    for (int unit = blockIdx.x; unit < 2 * 384; unit += G) {
        const int l = unit / 384, n0 = (unit % 384) * 32;
        const float* w = a.in[4] + (size_t)l * 2048 * 12288 + n0 + cgp * 4;
        f32x4 acc[5];
#pragma unroll
        for (int r = 0; r < 5; ++r) acc[r] = (f32x4){0.f, 0.f, 0.f, 0.f};
#pragma unroll 8
        for (int kk = 0; kk < 32; ++kk) {
            const int k = kg * 32 + kk;
            const f32x4 wv = __builtin_nontemporal_load((const f32x4*)(w + (size_t)k * 12288));
#pragma unroll
            for (int r = 0; r < 5; ++r) acc[r] += wv * act[r * 2048 + k];
        }
#pragma unroll
        for (int r = 0; r < 5; ++r)
#pragma unroll
            for (int j = 0; j < 4; ++j) red[(kg * 5 + r) * 32 + cgp * 4 + j] = acc[r][j];
        __syncthreads();
        if (tid < 160) { const int r = tid >> 5, col = tid & 31; float s = 0.f;
            for (int q = 0; q < 64; ++q) s += red[(q * 5 + r) * 32 + col];
            ada[(size_t)(l * 5 + r) * 12288 + n0 + col] = s + a.in[5][l * 12288 + n0 + col]; }
        __syncthreads();
    }
}

__device__ __forceinline__ void phase_rope_table(const Args& a) {
    if (blockIdx.x != 0) return;
    float* tab = (float*)(a.ws + WS_ROPE);
    for (int e = threadIdx.x; e < 1024; e += NTH) {
        const int pos = e >> 4, i = e & 15;
        double inv = 1.0; for (int q = 0; q < i; ++q) inv *= 0.56234132519034908;
        const float ang = (float)pos * (float)inv;
        double x = (double)ang;
        const double kq = rint(x * 0.15915494309189535);
        x = (x - kq * 6.283185307179586) - kq * 2.4492935982947064e-16;
        const double x2 = x * x;
        double ts = x, ss = x, tc = 1.0, cs = 1.0;
        for (int q = 1; q <= 15; ++q) { ts *= -x2 / (double)((2 * q) * (2 * q + 1)); ss += ts; tc *= -x2 / (double)((2 * q - 1) * (2 * q)); cs += tc; }
        tab[e * 2] = (float)cs; tab[e * 2 + 1] = (float)ss;
    }
}

__device__ __forceinline__ void phase_init_u(const Args& a) {
    const int tid_ = opaque_tid(); const int lane = tid_ & 63, gw = blockIdx.x * 8 + (tid_ >> 6), nw = gridDim.x * 8;
    float* XV = (float*)(a.ws + WS_XV); bf16_t* U = (bf16_t*)(a.ws + WS_U);
    const float* ada = (const float*)(a.ws + WS_ADA);
    for (int R = gw; R < MR; R += nw) {
        const float* src = R < CR ? a.in[2] + (size_t)R * 2048 : a.in[0] + (size_t)(R - CR) * 2048;
        const float* ar = ada + (size_t)ada_row(R) * 12288;
#pragma unroll
        for (int i = 0; i < 8; ++i) {
            const int c = (i * 64 + lane) * 4;
            const f32x4 v = *(const f32x4*)(src + c);
            *(f32x4*)(XV + (size_t)R * 2048 + c) = v;
            const f32x4 sh = *(const f32x4*)(ar + c), sc = *(const f32x4*)(ar + 2048 + c);
            *(u32x2*)(U + (size_t)R * 2048 + c) = pg8::pack4(v * (sc + 1.0f) + sh);
        }
    }
}

__device__ __forceinline__ void phase_ln(const Args& a, int R0, const float* g, const float* b, const float* mod  , float* out, const float* part = nullptr, int npart = 0, const float* cgate = nullptr) {
    const int tid_ = opaque_tid(); const int lane = tid_ & 63, gw = blockIdx.x * 8 + (tid_ >> 6), nw = gridDim.x * 8;
    float* XV = (float*)(a.ws + WS_XV); bf16_t* U = (bf16_t*)(a.ws + WS_U);
    f32x4 vn[8];
    if (R0 + gw < MR) {
#pragma unroll
        for (int i = 0; i < 8; ++i) vn[i] = *(const f32x4*)(XV + (size_t)(R0 + gw) * 2048 + (i * 64 + lane) * 4);
    }
    for (int R = R0 + gw; R < MR; R += nw) {
        f32x4 v[8]; float s = 0.f;
#pragma unroll
        for (int i = 0; i < 8; ++i) v[i] = vn[i];
        if (R + nw < MR) {
#pragma unroll
            for (int i = 0; i < 8; ++i) vn[i] = *(const f32x4*)(XV + (size_t)(R + nw) * 2048 + (i * 64 + lane) * 4);
        }
        if (npart && R < CR) {
#pragma unroll
            for (int i = 0; i < 8; ++i) {
                const int c = (i * 64 + lane) * 4; f32x4 acc = (f32x4){0.f, 0.f, 0.f, 0.f};
                for (int z = 0; z < npart; ++z) acc += *(const f32x4*)(part + ((size_t)z * CR + R) * 2048 + c);
                v[i] = v[i] * ALPHA + *(const f32x4*)(cgate + c) * acc;
            }
        }
#pragma unroll
        for (int i = 0; i < 8; ++i) s += (v[i][0] + v[i][1]) + (v[i][2] + v[i][3]);
        const float mean = wave_sum(s) * (1.0f / 2048.0f);
        float q = 0.f;
#pragma unroll
        for (int i = 0; i < 8; ++i) { v[i] = v[i] - mean; q += (v[i][0] * v[i][0] + v[i][1] * v[i][1]) + (v[i][2] * v[i][2] + v[i][3] * v[i][3]); }
        const float rstd = rsqrtf(wave_sum(q) * (1.0f / 2048.0f) + 1e-5f);
        const float* ar = mod ? mod + (size_t)ada_row(R) * 12288 : nullptr;
#pragma unroll
        for (int i = 0; i < 8; ++i) {
            const int c = (i * 64 + lane) * 4;
            const f32x4 y = v[i] * rstd * *(const f32x4*)(g + c) + *(const f32x4*)(b + c);
            if (out) { *(f32x4*)(out + (size_t)(R - CR) * 2048 + c) = y; }
            else {
                *(f32x4*)(XV + (size_t)R * 2048 + c) = y;
                const f32x4 sh = *(const f32x4*)(ar + c), sc = *(const f32x4*)(ar + 2048 + c);
                *(u32x2*)(U + (size_t)R * 2048 + c) = pg8::pack4(y * (sc + 1.0f) + sh);
            }
        }
    }
}

__device__ __forceinline__ void phase_svt(LAS unsigned char* lds, const Args& a) {
    LAS bf16_t* T = (LAS bf16_t*)lds;
    const bf16_t* P = (const bf16_t*)(a.ws + WS_PROJ); bf16_t* SVT = (bf16_t*)(a.ws + WS_SVT);
    const int tid = opaque_tid();
    for (int tile = blockIdx.x; tile < MR / 64; tile += gridDim.x) {
        const int R0 = tile * 64;
        __syncthreads();
#pragma unroll
        for (int p = 0; p < 4; ++p) { const int idx = tid + p * NTH, tok = idx >> 5, c8 = (idx & 31) * 8;
            const u32x4 w = *(const u32x4*)(P + (size_t)(R0 + tok) * LDP + 4160 + c8);
            LAS unsigned* d = (LAS unsigned*)(T + tok * 258 + c8); d[0] = w.x; d[1] = w.y; d[2] = w.z; d[3] = w.w; }
        __syncthreads();
#pragma unroll
        for (int p = 0; p < 4; ++p) { const int idx = tid + p * NTH, vr = idx & 255, kc = (idx >> 8) * 8;
            u32x4 w;
            w.x = (unsigned)T[(kc + 0) * 258 + vr] | ((unsigned)T[(kc + 1) * 258 + vr] << 16); w.y = (unsigned)T[(kc + 2) * 258 + vr] | ((unsigned)T[(kc + 3) * 258 + vr] << 16);
            w.z = (unsigned)T[(kc + 4) * 258 + vr] | ((unsigned)T[(kc + 5) * 258 + vr] << 16); w.w = (unsigned)T[(kc + 6) * 258 + vr] | ((unsigned)T[(kc + 7) * 258 + vr] << 16);
            *(u32x4*)(SVT + (size_t)vr * MR + R0 + kc) = w; }
    }
    __syncthreads();
}

template <int DK, int DK1, int DV, bool MASK, int VAR>
__device__ __forceinline__ void attn_unit(LAS unsigned char* lds, const bf16_t* Qp, int ldq, const bf16_t* K1, int ldk1, const bf16_t* K2, int ldk2, const bf16_t* Vt,
                                          int seg0, int n0t, int seg1, int n1t, int qpos0, int kpos1, float m0, float l0, float scale_log2, bf16_t* Op, int ldo) {
    constexpr int KST = DK * 2, KSZ = 64 * KST, VST = 128, VSZ = DV * VST;
    constexpr int NKC = (64 * DK / 8) / NTH, NVC = (DV * 8) / NTH, NKS = DK / 32, NDT = DV / 16;
    const int tid = opaque_tid(), wave = tid >> 6, lane = tid & 63, fr = lane & 15, g = lane >> 4;
    bf16x8 qf[2][NKS];
#pragma unroll
    for (int qs = 0; qs < 2; ++qs)
#pragma unroll
        for (int ks = 0; ks < NKS; ++ks) qf[qs][ks] = *(const bf16x8*)(Qp + (size_t)(wave * 32 + qs * 16 + fr) * ldq + ks * 32 + g * 8);
    f32x4 O[NDT][2];
#pragma unroll
    for (int dt = 0; dt < NDT; ++dt) { O[dt][0] = (f32x4){0.f, 0.f, 0.f, 0.f}; O[dt][1] = (f32x4){0.f, 0.f, 0.f, 0.f}; }
    float mrun[2] = {m0, m0}, lsum[2] = {g == 0 ? l0 : 0.f, g == 0 ? l0 : 0.f};
    const int nt = n0t + n1t;
    const int grp = wave >> 2;
    const int wv = __builtin_amdgcn_readfirstlane(wave);
    constexpr int NKW = KSZ / 1024, KWPW = (NKW + 7) / 8, NVW = VSZ / 1024, VWPW = (NVW + 7) / 8;
    static_assert(KSZ % 8192 == 0 && VSZ % 8192 == 0, "tile images are whole wave-loads, equal per wave");
    int koff[KWPW], voff[VWPW]; unsigned ksel = 0u;
#pragma unroll
    for (int i = 0; i < KWPW; ++i) {
        const int wl = wave + 8 * i, o = wl * 1024 + lane * 16, row = o / KST, pc = (o - row * KST) >> 4, ch = (pc & ~7) + ((pc & 7) ^ ((row >> 1) & 7));
        const int srow = (row & 32) + 8 * ((row >> 2) & 3) + 4 * ((row >> 4) & 1) + (row & 3);
        if (ch < DK1 / 8) koff[i] = srow * ldk1 + ch * 8; else { koff[i] = srow * ldk2 + (ch - DK1 / 8) * 8; ksel |= 1u << i; }
    }
#pragma unroll
    for (int i = 0; i < VWPW; ++i) {
        const int wl = wave + 8 * i, o = wl * 1024 + lane * 16, row = o >> 7, pc = (o & 127) >> 4, ch = pc ^ ((row >> 1) & 7);
        voff[i] = row * MR + ch * 8;
    }
    const int swz = (fr >> 1) & 7, offE = (g ^ swz) * 16, offO = ((4 + g) ^ swz) * 16;
#define ATT_DMA_K(trow, buf) do { const bf16_t* b1_ = K1 + (size_t)(trow) * ldk1; const bf16_t* b2_ = (DK1 < DK) ? K2 + (size_t)(trow) * ldk2 : b1_; \
        _Pragma("unroll") for (int i = 0; i < KWPW; ++i) if (koff[i] >= 0) { const bf16_t* src_ = ((DK1 < DK) && ((ksel >> i) & 1u)) ? b2_ + koff[i] : b1_ + koff[i]; \
            __builtin_amdgcn_global_load_lds((const unsigned*)src_, (LAS unsigned*)(lds + (buf) * KSZ + (wv + 8 * i) * 1024), 16, 0, 0); } } while (0)
#define ATT_DMA_V(trow, buf) do { const bf16_t* bv_ = Vt + (trow); \
        _Pragma("unroll") for (int i = 0; i < VWPW; ++i) if (voff[i] >= 0) \
            __builtin_amdgcn_global_load_lds((const unsigned*)(bv_ + voff[i]), (LAS unsigned*)(lds + 2 * KSZ + (buf) * VSZ + (wv + 8 * i) * 1024), 16, 0, 0); } while (0)
#define ATT_VMWAIT asm volatile("s_waitcnt vmcnt(0)" ::: "memory")
#define ATT_ROW(t) ((t) < n0t ? seg0 + (t) * 64 : seg1 + ((t) - n0t) * 64)
#define ATT_BAR do { asm volatile("s_waitcnt lgkmcnt(0)" ::: "memory"); __builtin_amdgcn_s_barrier(); asm volatile("" ::: "memory"); } while (0)
#define ATT_KLD(dst, i) dst = *(const LAS bf16x8*)(kb + ((i) & 3) * 16 * KST + ((i) >> 3) * 128 + ((((i) >> 2) & 1) ? offO : offE))
#define ATT_X(bufk) do { const LAS unsigned char* kb = lds + (bufk) * KSZ + fr * KST; \
        constexpr int XG = 2, NXG = NKS * 4 / XG;     \
        bf16x8 afr[2][XG]; \
        _Pragma("unroll") for (int q = 0; q < XG; ++q) ATT_KLD(afr[0][q], q); \
        _Pragma("unroll") for (int gi = 0; gi < NXG; ++gi) { \
            if (gi + 1 < NXG) { _Pragma("unroll") for (int q = 0; q < XG; ++q) ATT_KLD(afr[(gi + 1) & 1][q], (gi + 1) * XG + q); } \
            __builtin_amdgcn_sched_barrier(0); \
            _Pragma("unroll") for (int q = 0; q < XG; ++q) { const int i_ = gi * XG + q, kt = i_ & 3, ks = i_ >> 2; \
                s[kt][0] = __builtin_amdgcn_mfma_f32_16x16x32_bf16(afr[gi & 1][q], qf[0][ks], ks == 0 ? (f32x4){0.f, 0.f, 0.f, 0.f} : s[kt][0], 0, 0, 0); \
                s[kt][1] = __builtin_amdgcn_mfma_f32_16x16x32_bf16(afr[gi & 1][q], qf[1][ks], ks == 0 ? (f32x4){0.f, 0.f, 0.f, 0.f} : s[kt][1], 0, 0, 0); } \
            __builtin_amdgcn_sched_barrier(0); } } while (0)
    f32x4 s[4][2];
    bf16x8 pf[2][2];
    __syncthreads();
    ATT_DMA_K(ATT_ROW(0), 0); ATT_DMA_V(ATT_ROW(0), 0); ATT_DMA_K(ATT_ROW(1), 1);
    ATT_VMWAIT;
    __syncthreads();
    if (grp == 1) ATT_BAR;
    ATT_X(0);
    ATT_BAR;
#pragma nounroll
    for (int t = 0; t < nt; ++t) {
        if (grp == 1) { if (t + 2 < nt) ATT_DMA_K(ATT_ROW(t + 2), t & 1); if (t + 1 < nt) ATT_DMA_V(ATT_ROW(t + 1), (t + 1) & 1); }
        const bool masked = MASK && (t >= n0t);
        const int kp0 = kpos1 + (t - n0t) * 64 + g * 8;
#pragma unroll
        for (int qs = 0; qs < 2; ++qs) {
            const int qp = qpos0 + wave * 32 + qs * 16 + fr;
            float mx = -INFINITY;
#pragma unroll
            for (int kt = 0; kt < 4; ++kt)
#pragma unroll
                for (int j = 0; j < 4; ++j) {
                    float v = s[kt][qs][j];
                    if (masked) { const int dlt = kp0 + (kt >> 1) * 32 + (kt & 1) * 4 + j - qp; if (dlt > 128 || dlt < -128) v = -INFINITY; s[kt][qs][j] = v; }
                    mx = fmaxf(mx, v);
                }
            mx = fmaxf(mx, __shfl_xor(mx, 16)); mx = fmaxf(mx, __shfl_xor(mx, 32));
            const float mn = fmaxf(mrun[qs], mx);
            const float al = __builtin_amdgcn_exp2f(mrun[qs] - mn);
            mrun[qs] = mn;
#pragma unroll
            for (int dt = 0; dt < NDT; ++dt) O[dt][qs] = O[dt][qs] * al;
            float ps = 0.f;
#pragma unroll
            for (int kt = 0; kt < 4; ++kt)
#pragma unroll
                for (int j = 0; j < 4; ++j) { const float p = __builtin_amdgcn_exp2f(s[kt][qs][j] - mn); s[kt][qs][j] = p; ps += p; }
            lsum[qs] = lsum[qs] * al + ps;
#pragma unroll
            for (int s2 = 0; s2 < 2; ++s2) {
                u32x4 w; w.x = cvt_pk_bf16(s[2 * s2][qs][0], s[2 * s2][qs][1]); w.y = cvt_pk_bf16(s[2 * s2][qs][2], s[2 * s2][qs][3]);
                w.z = cvt_pk_bf16(s[2 * s2 + 1][qs][0], s[2 * s2 + 1][qs][1]); w.w = cvt_pk_bf16(s[2 * s2 + 1][qs][2], s[2 * s2 + 1][qs][3]);
                pf[qs][s2] = __builtin_bit_cast(bf16x8, w);
            }
        }
        if (grp == 0) ATT_VMWAIT;
        ATT_BAR;
        if (grp == 0) { if (t + 2 < nt) ATT_DMA_K(ATT_ROW(t + 2), t & 1); if (t + 1 < nt) ATT_DMA_V(ATT_ROW(t + 1), (t + 1) & 1); }
        {
            const LAS unsigned char* vb = lds + 2 * KSZ + (t & 1) * VSZ + fr * VST;
            constexpr int NIT = 2 * NDT, GSZ = 2, NGR = NIT / GSZ;
            bf16x8 vf[2][GSZ];
#define ATT_VLD(dst, i) dst = *(const LAS bf16x8*)(vb + ((i) % NDT) * 16 * VST + (((i) / NDT) ? offO : offE))
#pragma unroll
            for (int q = 0; q < GSZ; ++q) ATT_VLD(vf[0][q], q);
#pragma unroll
            for (int gi = 0; gi < NGR; ++gi) {
                if (gi + 1 < NGR) {
#pragma unroll
                    for (int q = 0; q < GSZ; ++q) ATT_VLD(vf[(gi + 1) & 1][q], (gi + 1) * GSZ + q);
                }
                __builtin_amdgcn_sched_barrier(0);
#pragma unroll
                for (int q = 0; q < GSZ; ++q) {
                    const int i = gi * GSZ + q, dt = i % NDT, s2 = i / NDT;
                    O[dt][0] = __builtin_amdgcn_mfma_f32_16x16x32_bf16(vf[gi & 1][q], pf[0][s2], O[dt][0], 0, 0, 0);
                    O[dt][1] = __builtin_amdgcn_mfma_f32_16x16x32_bf16(vf[gi & 1][q], pf[1][s2], O[dt][1], 0, 0, 0);
                }
                __builtin_amdgcn_sched_barrier(0);
            }
#undef ATT_VLD
        }
        if (t + 1 < nt) ATT_X((t + 1) & 1);
        if (grp == 1) ATT_VMWAIT;
        ATT_BAR;
    }
    if (grp == 0) ATT_BAR;
#pragma unroll
    for (int qs = 0; qs < 2; ++qs) {
        float l = lsum[qs]; l += __shfl_xor(l, 16); l += __shfl_xor(l, 32);
        const float inv = 1.0f / l;
        bf16_t* orow = Op + (size_t)(wave * 32 + qs * 16 + fr) * ldo + g * 4;
#pragma unroll
        for (int dt = 0; dt < NDT; ++dt) *(u32x2*)(orow + dt * 16) = pg8::pack4(O[dt][qs] * inv);
    }
#undef ATT_DMA_K
#undef ATT_DMA_V
#undef ATT_VMWAIT
#undef ATT_ROW
#undef ATT_BAR
#undef ATT_X
#undef ATT_KLD
}

template <int VAR>
__device__ __forceinline__ void phase_attention(LAS unsigned char* lds, const Args& a, int l, bool need_ctx) {
    const bf16_t* P = (const bf16_t*)(a.ws + WS_PROJ); const bf16_t* QB = (const bf16_t*)(a.ws + WS_QB); const bf16_t* KN = (const bf16_t*)(a.ws + WS_KN);
    const bf16_t* VT = (const bf16_t*)(a.ws + WS_VT); const bf16_t* SVT = (const bf16_t*)(a.ws + WS_SVT); bf16_t* Y = (bf16_t*)(a.ws + (VAR ? WS_END : WS_Y));
    const int G = gridDim.x;
    const int nmla = 256 + (need_ctx ? 32 : 0), nswa = 512 + (need_ctx ? 64 : 0);
    const float mla_sc = 0.07216878364870322f * LOG2E, swa_sc = 0.125f * LOG2E;
    for (int un = blockIdx.x; un < nmla + nswa; un += G) {
        if (VAR == 2 && un >= nmla) continue;
        if (VAR == 3 && un < nmla) continue;
        if (un < nmla) {
            if (un < 256) {
                const int xcd = un & 7, slot = un >> 3, pair = xcd * 4 + (slot >> 3);
                const int b = pair >> 3, h = pair & 7, qb = slot & 7;
                const int qrow = CR + b * SEQ + qb * 256;
                attn_unit<192, 128, 128, false, VAR>(lds, QB + (size_t)qrow * 1536 + h * 192, 1536, KN + h * 128, 1024, P + 2816, LDP, VT + (size_t)h * 128 * MR,
                                                b * CTXL, 4, CR + b * SEQ, 32, 0, 0, -INFINITY, 0.f, mla_sc, Y + (size_t)qrow * 3072 + 1024 + h * 128, 3072);
            } else {
                const int u2 = un - 256, b = u2 >> 3, h = u2 & 7;
                const int qrow = b * CTXL;
                attn_unit<192, 128, 128, false, VAR>(lds, QB + (size_t)qrow * 1536 + h * 192, 1536, KN + h * 128, 1024, P + 2816, LDP, VT + (size_t)h * 128 * MR,
                                                b * CTXL, 4, 0, 0, 0, 0, -INFINITY, 0.f, mla_sc, Y + (size_t)qrow * 3072 + 1024 + h * 128, 3072);
            }
        } else {
            const int us = un - nmla;
            if (us < 512) {
                const int xcd = us & 7, slot = ((us >> 3) & 31) + 32 * (us >> 8), pair = xcd * 2 + (slot >> 5);
                const int b = pair >> 2, gk = pair & 3, h = gk * 4 + ((slot >> 3) & 3), qb = slot & 7;
                const int q0 = qb * 256, qrow = CR + b * SEQ + q0;
                const int ks = q0 >= 128 ? q0 - 128 : 0, ke = q0 + 384 < SEQ ? q0 + 384 : SEQ;
                const float sink = a.in[18][l * 16 + h] * LOG2E;
                attn_unit<64, 64, 64, true, VAR>(lds, P + (size_t)qrow * LDP + 2880 + h * 64, LDP, P + 3904 + gk * 64, LDP, nullptr, 0, SVT + (size_t)gk * 64 * MR,
                                            b * CTXL, 4, CR + b * SEQ + ks, (ke - ks) >> 6, q0, ks, sink, 1.0f, swa_sc, Y + (size_t)qrow * 3072 + 2048 + h * 64, 3072);
            } else {
                const int u2 = us - 512, b = u2 >> 4, h = u2 & 15, gk = h >> 2;
                const int qrow = b * CTXL;
                const float sink = a.in[18][l * 16 + h] * LOG2E;
                attn_unit<64, 64, 64, true, VAR>(lds, P + (size_t)qrow * LDP + 2880 + h * 64, LDP, P + 3904 + gk * 64, LDP, nullptr, 0, SVT + (size_t)gk * 64 * MR,
                                            b * CTXL, 4, 0, 0, 0, 0, sink, 1.0f, swa_sc, Y + (size_t)qrow * 3072 + 2048 + h * 64, 3072);
            }
        }
    }
}

__device__ __forceinline__ float gelu_tanh(float x) {
    const float u2 = 1.5957691216057308f * (x + 0.044715f * x * x * x);
    return x * __builtin_amdgcn_rcpf(1.0f + __builtin_amdgcn_exp2f(-u2 * LOG2E));
}
__device__ __forceinline__ void chunk_info(int ck, int& b, int& cs, int& seqrow0, int& seqlen) {
    if (ck < 16) { b = ck >> 2; cs = ck & 3; seqrow0 = b * CTXL; seqlen = CTXL; } else { const int k2 = ck - 16; b = k2 >> 5; cs = k2 & 31; seqrow0 = CR + b * SEQ; seqlen = SEQ; }
}
__device__ __forceinline__ void lruA_prefetch(const bf16_t* P, int ck, int n, int tid, u32x4 (&raw)[3]) {
    int b, cs, seqrow0, seqlen; chunk_info(ck, b, cs, seqrow0, seqlen);
#pragma unroll
    for (int i = 0; i < 3; ++i) {
        const int idx = tid + i * NTH, rr = idx >> 4, c8 = (idx & 15) * 8, tp = cs * 64 + rr - 2;
        raw[i] = (u32x4){0u, 0u, 0u, 0u};
        if (idx < 67 * 16 && tp >= 0 && tp < seqlen) raw[i] = *(const u32x4*)(P + (size_t)(seqrow0 + tp) * LDP + n * 128 + c8);
    }
}
__device__ __forceinline__ void lruA_unit(LAS unsigned char* lds, const Args& a, int l, int ck, int n, u32x4 (&raw)[3], int nck, int nn, bool has_next) {
    LAS float* Xraw = (LAS float*)lds;
    LAS bf16_t* Xb = (LAS bf16_t*)(lds + 34304);
    LAS float* Ab = (LAS float*)(lds + 51712);
    LAS float* Bb = (LAS float*)(lds + 84480);
    LAS float* SegP = (LAS float*)(lds + 117248); LAS float* SegH = SegP + 512; LAS float* CarP = SegP + 1024; LAS float* CarH = SegP + 1536;
    const bf16_t* P = (const bf16_t*)(a.ws + WS_PROJ);
    bf16_t* HL = (bf16_t*)(a.ws + WS_U); bf16_t* PC = (bf16_t*)(a.ws + WS_MB);
    f32x2* SUM = (f32x2*)(a.ws + WS_SUM);
    const bf16_t* WL = (const bf16_t*)(a.ws + (size_t)l * W_LAYER + OW_LRU);
    const int tid = opaque_tid(), wave = tid >> 6, lane = tid & 63, fr = lane & 15, g = lane >> 4;
    int b, cs, seqrow0, seqlen; chunk_info(ck, b, cs, seqrow0, seqlen);
    const int R0 = seqrow0 + cs * 64;
    __syncthreads();
#pragma unroll
    for (int i = 0; i < 3; ++i) {
        const int idx = tid + i * NTH, rr = idx >> 4, c8 = (idx & 15) * 8;
        if (idx < 67 * 16) { LAS float* d = Xraw + rr * 128 + c8; const u32x4 w = raw[i];
            d[0] = bflo(w.x); d[1] = bfhi(w.x); d[2] = bflo(w.y); d[3] = bfhi(w.y); d[4] = bflo(w.z); d[5] = bfhi(w.z); d[6] = bflo(w.w); d[7] = bfhi(w.w); }
    }
    const int ko = wave * 16 + fr, cch = n * 128 + ko;
    bf16x8 wf[2][2][4];
#pragma unroll
    for (int d = 0; d < 2; ++d)
#pragma unroll
        for (int ri = 0; ri < 2; ++ri)
#pragma unroll
            for (int ks = 0; ks < 4; ++ks) wf[d][ri][ks] = *(const bf16x8*)(WL + ((size_t)((d * 2 + ri) * 8 + n) * 128 + ko) * 128 + ks * 32 + g * 8);
    __syncthreads();
    {
        const int ch = tid & 127, tq = tid >> 7, c2 = n * 128 + ch;
        const float* cw = a.in[7] + (size_t)l * 4 * 1024 + c2;
        const float w0 = cw[0], w1 = cw[1024], w2 = cw[2048], w3 = cw[3072], cb = a.in[8][l * 1024 + c2];
#pragma unroll 4
        for (int i = 0; i < 16; ++i) { const int t = tq * 16 + i;
            const float x = w0 * Xraw[t * 128 + ch] + w1 * Xraw[(t + 1) * 128 + ch] + w2 * Xraw[(t + 2) * 128 + ch] + w3 * Xraw[(t + 3) * 128 + ch] + cb;
            Xb[t * 136 + ch] = (bf16_t)(cvt_pk_bf16(x, 0.f) & 0xffffu); }
    }
    if (has_next) lruA_prefetch(P, nck, nn, tid, raw);
    __syncthreads();
#pragma unroll
    for (int d = 0; d < 2; ++d) {
        {
            f32x4 ar[4], ai[4];
#pragma unroll
            for (int tt = 0; tt < 4; ++tt) { ar[tt] = (f32x4){0.f, 0.f, 0.f, 0.f}; ai[tt] = (f32x4){0.f, 0.f, 0.f, 0.f}; }
            bf16x8 xa[4][4];
#pragma unroll
            for (int ks = 0; ks < 4; ++ks)
#pragma unroll
                for (int tt = 0; tt < 4; ++tt) xa[ks][tt] = *(const LAS bf16x8*)(Xb + (tt * 16 + fr) * 136 + ks * 32 + g * 8);
            bf16_t xv[4][4];
#pragma unroll
            for (int tt = 0; tt < 4; ++tt)
#pragma unroll
                for (int j = 0; j < 4; ++j) xv[tt][j] = Xb[(tt * 16 + g * 4 + j) * 136 + ko];
            __builtin_amdgcn_sched_barrier(0);
#pragma unroll
            for (int ks = 0; ks < 4; ++ks)
#pragma unroll
                for (int tt = 0; tt < 4; ++tt) {
                    ar[tt] = __builtin_amdgcn_mfma_f32_16x16x32_bf16(xa[ks][tt], wf[d][0][ks], ar[tt], 0, 0, 0);
                    ai[tt] = __builtin_amdgcn_mfma_f32_16x16x32_bf16(xa[ks][tt], wf[d][1][ks], ai[tt], 0, 0, 0);
                }
            const float biasr = a.in[10][(size_t)(l * 2 + d) * 1024 + cch] * -LOG2E, biasi = a.in[12][(size_t)(l * 2 + d) * 1024 + cch] * -LOG2E;
            const float sp8 = 8.0f * log1pf(__expf(-a.in[13][(size_t)(l * 2 + d) * 1024 + cch]));
#pragma unroll
            for (int tt = 0; tt < 4; ++tt)
#pragma unroll
                for (int j = 0; j < 4; ++j) {
                    const int tok = tt * 16 + g * 4 + j;
                    const float r = __builtin_amdgcn_rcpf(1.0f + __builtin_amdgcn_exp2f(ar[tt][j] * -LOG2E + biasr));
                    const float ig = __builtin_amdgcn_rcpf(1.0f + __builtin_amdgcn_exp2f(ai[tt][j] * -LOG2E + biasi));
                    const float la = -sp8 * r, aa = __builtin_amdgcn_exp2f(la * LOG2E), z = 2.0f * la;
                    const float ser = -z * (1.0f + z * (0.5f + z * (0.16666667f + z * (0.041666668f + z * (0.0083333338f + z * 0.0013888889f)))));
                    const float em = z > -0.25f ? ser : 1.0f - aa * aa;
                    Ab[tok * 128 + ko] = aa; Bb[tok * 128 + ko] = __builtin_amdgcn_sqrtf(em) * ig * bf2f(xv[tt][j]);
                }
        }
        __syncthreads();
        const int seg = tid >> 7, ch = tid & 127;
        {
            float cp = 1.f, h = 0.f;
#pragma unroll
            for (int i = 0; i < 16; ++i) { const int t = d ? seg * 16 + 15 - i : seg * 16 + i; const float aa = Ab[t * 128 + ch]; h = aa * h + Bb[t * 128 + ch]; cp *= aa; Ab[t * 128 + ch] = cp; Bb[t * 128 + ch] = h; }
            SegP[seg * 128 + ch] = cp; SegH[seg * 128 + ch] = h;
        }
        __syncthreads();
        {
            float cP = 1.f, cH = 0.f;
            if (d == 0) { for (int s2 = 0; s2 < seg; ++s2) { const float p = SegP[s2 * 128 + ch]; cH = p * cH + SegH[s2 * 128 + ch]; cP *= p; } }
            else { for (int s2 = 3; s2 > seg; --s2) { const float p = SegP[s2 * 128 + ch]; cH = p * cH + SegH[s2 * 128 + ch]; cP *= p; } }
            CarP[seg * 128 + ch] = cP; CarH[seg * 128 + ch] = cH;
            if (seg == (d ? 0 : 3)) { const float p = SegP[seg * 128 + ch]; SUM[((size_t)(d * 144 + ck)) * 1024 + n * 128 + ch] = (f32x2){p * cP, p * cH + SegH[seg * 128 + ch]}; }
        }
        __syncthreads();
#pragma unroll
        for (int p = 0; p < 2; ++p) {
            const int idx = tid + p * NTH, tok = idx >> 4, c8 = (idx & 15) * 8, sg = tok >> 4;
            float hl[8], pc[8];
#pragma unroll
            for (int e = 0; e < 8; ++e) { const float pl = Ab[tok * 128 + c8 + e]; hl[e] = Bb[tok * 128 + c8 + e] + pl * CarH[sg * 128 + c8 + e]; pc[e] = pl * CarP[sg * 128 + c8 + e]; }
            u32x4 wh, wp;
            wh.x = cvt_pk_bf16(hl[0], hl[1]); wh.y = cvt_pk_bf16(hl[2], hl[3]); wh.z = cvt_pk_bf16(hl[4], hl[5]); wh.w = cvt_pk_bf16(hl[6], hl[7]);
            wp.x = cvt_pk_bf16(pc[0], pc[1]); wp.y = cvt_pk_bf16(pc[2], pc[3]); wp.z = cvt_pk_bf16(pc[4], pc[5]); wp.w = cvt_pk_bf16(pc[6], pc[7]);
            const size_t o = ((size_t)d * MR + R0 + tok) * 1024 + n * 128 + c8;
            *(u32x4*)(HL + o) = wh; *(u32x4*)(PC + o) = wp;
        }
        if (d == 0) __syncthreads();
    }
}
__device__ __forceinline__ void phase_lruA(LAS unsigned char* lds, const Args& a, int l) {
    const int G = gridDim.x, nun = 144 * 8, tid = opaque_tid();
    const bf16_t* P = (const bf16_t*)(a.ws + WS_PROJ);
    u32x4 raw[3];
    int un = blockIdx.x;
    if (un < nun) lruA_prefetch(P, un >> 3, un & 7, tid, raw);
    for (; un < nun; un += G) { const int nx = un + G; lruA_unit(lds, a, l, un >> 3, un & 7, raw, nx >> 3, nx & 7, nx < nun); }
    __syncthreads();
}

__device__ __forceinline__ void lruC_unit(LAS unsigned char* lds, const Args& a, int ck, int n) {
    LAS float* Car = (LAS float*)lds;
    const bf16_t* P = (const bf16_t*)(a.ws + WS_PROJ); bf16_t* Y = (bf16_t*)(a.ws + WS_Y);
    const bf16_t* HL = (const bf16_t*)(a.ws + WS_U); const bf16_t* PC = (const bf16_t*)(a.ws + WS_MB);
    const f32x2* SUM = (const f32x2*)(a.ws + WS_SUM);
    const int tid = opaque_tid();
    int b, cs, seqrow0, seqlen; chunk_info(ck, b, cs, seqrow0, seqlen);
    const int R0 = seqrow0 + cs * 64;
    u32x4 h0[2], p0[2], h1[2], p1[2], ag[2];
#pragma unroll
    for (int p = 0; p < 2; ++p) {
        const int idx = tid + p * NTH, tok = idx >> 4, c8 = (idx & 15) * 8;
        const size_t o = ((size_t)R0 + tok) * 1024 + n * 128 + c8;
        h0[p] = *(const u32x4*)(HL + o); p0[p] = *(const u32x4*)(PC + o); h1[p] = *(const u32x4*)(HL + (size_t)MR * 1024 + o); p1[p] = *(const u32x4*)(PC + (size_t)MR * 1024 + o);
        ag[p] = *(const u32x4*)(P + (size_t)(R0 + tok) * LDP + 1024 + n * 128 + c8);
    }
    __syncthreads();
    if (tid < 256) {
        const int d = tid >> 7, ch = tid & 127;
        const bool isctx = ck < 16;
        const int np = d == 0 ? (isctx ? cs : 4 + cs) : (isctx ? 3 - cs : 35 - cs);
        float carry = 0.f;
        for (int j0 = 0; j0 < np; j0 += 12) {
            f32x2 v[12];
#pragma unroll
            for (int q = 0; q < 12; ++q) {
                const int j = j0 + q; int cc;
                if (d == 0) cc = isctx ? b * 4 + j : (j < 4 ? b * 4 + j : 16 + b * 32 + (j - 4));
                else cc = isctx ? b * 4 + 3 - j : (j < 4 ? b * 4 + 3 - j : 16 + b * 32 + 31 - (j - 4));
                v[q] = (f32x2){1.f, 0.f};
                if (j < np) v[q] = SUM[((size_t)(d * 144 + cc)) * 1024 + n * 128 + ch];
            }
#pragma unroll
            for (int q = 0; q < 12; ++q) carry = v[q].x * carry + v[q].y;
        }
        Car[tid] = carry;
    }
    __syncthreads();
#pragma unroll
    for (int p = 0; p < 2; ++p) {
        const int idx = tid + p * NTH, tok = idx >> 4, c8 = (idx & 15) * 8;
        const LAS float* cf = Car + c8; const LAS float* cb = Car + 128 + c8;
        float y[8];
#define LRUC_E(e, hw0, pw0, hw1, pw1, gw, HI) y[e] = ((HI ? bfhi(hw0) : bflo(hw0)) + (HI ? bfhi(pw0) : bflo(pw0)) * cf[e] + (HI ? bfhi(hw1) : bflo(hw1)) + (HI ? bfhi(pw1) : bflo(pw1)) * cb[e]) * gelu_tanh(HI ? bfhi(gw) : bflo(gw))
        LRUC_E(0, h0[p].x, p0[p].x, h1[p].x, p1[p].x, ag[p].x, 0); LRUC_E(1, h0[p].x, p0[p].x, h1[p].x, p1[p].x, ag[p].x, 1);
        LRUC_E(2, h0[p].y, p0[p].y, h1[p].y, p1[p].y, ag[p].y, 0); LRUC_E(3, h0[p].y, p0[p].y, h1[p].y, p1[p].y, ag[p].y, 1);
        LRUC_E(4, h0[p].z, p0[p].z, h1[p].z, p1[p].z, ag[p].z, 0); LRUC_E(5, h0[p].z, p0[p].z, h1[p].z, p1[p].z, ag[p].z, 1);
        LRUC_E(6, h0[p].w, p0[p].w, h1[p].w, p1[p].w, ag[p].w, 0); LRUC_E(7, h0[p].w, p0[p].w, h1[p].w, p1[p].w, ag[p].w, 1);
#undef LRUC_E
        u32x4 w; w.x = cvt_pk_bf16(y[0], y[1]); w.y = cvt_pk_bf16(y[2], y[3]); w.z = cvt_pk_bf16(y[4], y[5]); w.w = cvt_pk_bf16(y[6], y[7]);
        *(u32x4*)(Y + (size_t)(R0 + tok) * 3072 + n * 128 + c8) = w;
    }
}
__device__ __forceinline__ void phase_lruC(LAS unsigned char* lds, const Args& a, int ck0, int skew) {
    const int G = gridDim.x, nun = (144 - ck0) * 8;
    int first = (int)blockIdx.x - (skew % G); if (first < 0) first += G;
    for (int un = first; un < nun; un += G) lruC_unit(lds, a, ck0 + (un >> 3), un & 7);
    __syncthreads();
}

#define XB_TMO      128
#define XB_XCNT(j)  (256  + 64 * (j))
#define XB_XSUB(j)  (1280 + 64 * (j))
#define XB_XGEN(j)  (2304 + 64 * (j))
#define XB_TOP      3328
#define XB_TOPGEN   3392
#define XCD_BAR_WORDS 3456
#define XB_SPIN_CAP (1u << 18)
__device__ __forceinline__ unsigned xb_ld(unsigned* p)              { return __hip_atomic_load(p, __ATOMIC_RELAXED, __HIP_MEMORY_SCOPE_AGENT); }
__device__ __forceinline__ unsigned xb_add(unsigned* p, unsigned v) { return __hip_atomic_fetch_add(p, v, __ATOMIC_RELAXED, __HIP_MEMORY_SCOPE_AGENT); }
__device__ __forceinline__ unsigned xb_xcc_id() { return (unsigned)__builtin_amdgcn_s_getreg((3 << 11) | 20) & 0xFu; }
#define XB_SPIN(cond, bar) do { unsigned _sp = 0; while (cond) { __builtin_amdgcn_s_sleep(1); \
    if ((++_sp & 255u) == 0u) { if (xb_ld(&(bar)[XB_TMO])) break; if (_sp > XB_SPIN_CAP) { atomicAdd(&(bar)[XB_TMO], 1u); break; } } } } while (0)
struct XcdBarrier { unsigned* bar; unsigned x; volatile LAS unsigned* st; };
__device__ __forceinline__ XcdBarrier xcd_barrier_post(unsigned* bar, volatile LAS unsigned* st) {
    XcdBarrier b; b.bar = bar; b.x = xb_xcc_id(); b.st = st;
    if (threadIdx.x == 0) (void)xb_add(&bar[XB_XCNT(b.x)], 1u);
    return b;
}
__device__ __forceinline__ void xcd_barrier_complete(unsigned* bar, unsigned x, unsigned& nloc, unsigned& nx) {
    const unsigned G = gridDim.x * gridDim.y * gridDim.z;
    unsigned sum, cnt, mine, sp = 0u;
    for (;;) {
        sum = 0u; cnt = 0u; mine = 0u;
#pragma unroll
        for (unsigned j = 0; j < 16; ++j) { const unsigned c = xb_ld(&bar[XB_XCNT(j)]); sum += c; cnt += (c > 0u) ? 1u : 0u; mine = (j == x) ? c : mine; }
        if (sum == G) break;
        __builtin_amdgcn_s_sleep(1);
        if ((++sp & 255u) == 0u) { if (xb_ld(&bar[XB_TMO])) break; if (sp > XB_SPIN_CAP) { atomicAdd(&bar[XB_TMO], 1u); break; } }
    }
    nloc = mine > 0u ? mine : 1u; nx = cnt > 0u ? cnt : 1u;
}
__device__ __forceinline__ void xcd_barrier(const XcdBarrier& b) {
    asm volatile("s_waitcnt vmcnt(0)" ::: "memory");
    __syncthreads();
    if (threadIdx.x == 0) {
        unsigned* bar = b.bar;
        __builtin_amdgcn_s_waitcnt(0);
        unsigned nloc = b.st[0], nx = b.st[1];
        if (nloc == 0u) { xcd_barrier_complete(bar, b.x, nloc, nx); b.st[0] = nloc; b.st[1] = nx; }
        const unsigned old = xb_add(&bar[XB_XSUB(b.x)], 1u);
        const unsigned gen = old / nloc;
        if (old + 1u == (gen + 1u) * nloc) {
            __builtin_amdgcn_fence(__ATOMIC_RELEASE, "agent");
            asm volatile("s_waitcnt vmcnt(0)" ::: "memory");
            const unsigned og = xb_add(&bar[XB_TOP], 1u);
            const unsigned tg = og / nx;
            if (og + 1u == (tg + 1u) * nx) xb_add(&bar[XB_TOPGEN], 1u);
            else XB_SPIN(xb_ld(&bar[XB_TOPGEN]) == tg, bar);
            __builtin_amdgcn_fence(__ATOMIC_ACQUIRE, "agent");
            xb_add(&bar[XB_XGEN(b.x)], 1u);
            asm volatile("s_waitcnt vmcnt(0)" ::: "memory");
        } else {
            XB_SPIN(xb_ld(&bar[XB_XGEN(b.x)]) == gen, bar);
            __builtin_amdgcn_fence(__ATOMIC_ACQUIRE, "agent");
            asm volatile("s_waitcnt vmcnt(0)" ::: "memory");
        }
    }
    __syncthreads();
}

__global__ void __launch_bounds__(NTH) mega(Args a) {
    extern __shared__ __attribute__((aligned(16))) unsigned char lds_raw[];
    LAS unsigned char* lds = (LAS unsigned char*)lds_raw;
    cg::grid_group grid = cg::this_grid();
    if (threadIdx.x < 16) ((LAS unsigned*)(lds + 131072))[threadIdx.x] = 0u;
    __syncthreads();
    XcdBarrier xbar = xcd_barrier_post((unsigned*)(a.ws + WS_BAR), (volatile LAS unsigned*)(lds + 131072));
    const int G = gridDim.x, c = blockIdx.x;
    int ph = 0;
#ifndef SUB
#define SUB 0xFF
#endif
#ifndef PHMASK
#define PHMASK 0xFFFF
#endif
#ifndef ATTVAR
#define ATTVAR 2
#endif
#ifndef REPSUB
#define REPSUB 0
#endif
#ifndef REPMASK
#define REPMASK 0
#endif
#define PHASE_BEGIN(id) if ((((PHMASK) >> (id)) & 1) && ph >= a.ph_lo && ph < a.ph_hi) { for (int rep_ = 0; rep_ <= (((REPMASK) >> (id)) & 1); ++rep_) {
#ifndef REPSYNC
#define REPSYNC 0
#endif
#define PHASE_END   } if (ph + 1 < a.ph_hi) { if (a.ph_lo < 0) grid.sync(); for (int rs_ = 0; rs_ <= REPSYNC; ++rs_) xcd_barrier(xbar); } } ++ph;
    unsigned char* ws = a.ws;
    bf16_t* PROJ = (bf16_t*)(ws + WS_PROJ); bf16_t* U = (bf16_t*)(ws + WS_U); bf16_t* Y = (bf16_t*)(ws + WS_Y); bf16_t* QB = (bf16_t*)(ws + WS_QB);
    bf16_t* KN = (bf16_t*)(ws + WS_KN); bf16_t* VT = (bf16_t*)(ws + WS_VT); bf16_t* MB = (bf16_t*)(ws + WS_MB); bf16_t* H = PROJ;
    float* PART4 = (float*)(ws + WS_QB);
    float* PART = (float*)(ws + WS_Y);
    float* XV = (float*)(ws + WS_XV); float* ADA = (float*)(ws + WS_ADA); float* RMS = (float*)(ws + WS_RMS); const float* ROPE = (const float*)(ws + WS_ROPE);

    PHASE_BEGIN(0)
        phase_ada(lds, a); phase_rope_table(a); phase_convert(lds, a);
    PHASE_END
    PHASE_BEGIN(1)
        phase_init_u(a);
    PHASE_END
#pragma nounroll
    for (int l = 0; l < 2; ++l) {
        const bool need_ctx = (l == 0);
        const unsigned char* wl = ws + (size_t)l * W_LAYER;
        const int pm_lo = need_ctx ? 0 : 4, nMl = need_ctx ? 36 : 32;
        PHASE_BEGIN(2)
            pg8::Gemm g{U, (const bf16_t*)(wl + OW_IN), 2048, 2048, 2048, 0, 0};
            pg8::Sched<1> S; S.G = G; S.c = c;
            if (need_ctx) { S.a.init(36, 42, 0, 0); S.b.init(0, 1, 0, 0); } else { S.a.init(32, 42, 4, 0); S.b.init(4, 18, 0, 0); }
            pg8::EpiProj E{PROJ, ROPE, RMS};
            pg8::gemm_phase(lds, g, S, E);
        PHASE_END
        PHASE_BEGIN(3)
            if (SUB & 1) { pg8::Gemm g{PROJ + 2048, (const bf16_t*)(wl + OW_Q), LDP, 512, 512, 0, 0}; pg8::Sched<1> S; S.G = G; S.c = c; S.a.init(nMl, 6, pm_lo, 0); S.b.init(0, 1, 0, 0);
              pg8::EpiQ E{QB, ROPE, RMS}; pg8::gemm_phase(lds, g, S, E); }
            if (SUB & 2) { pg8::Gemm g{PROJ + 2560, (const bf16_t*)(wl + OW_K), LDP, 256, 256, 0, 0}; pg8::Sched<1> S; S.G = G; S.c = (c + 64) % G; S.a.init(36, 4, 0, 0); S.b.init(0, 1, 0, 0);
              pg8::EpiKN E{KN, RMS}; pg8::gemm_phase(lds, g, S, E); }
            if (SUB & 4) { pg8::Gemm g{(const bf16_t*)(wl + OW_V), PROJ + 2560, 256, LDP, 256, 0, 0}; pg8::Sched<1> S; S.G = G; S.c = (c + 128) % G; S.a.init(4, 36, 0, 0); S.b.init(0, 1, 0, 0);
              pg8::EpiVT E{VT, RMS}; pg8::gemm_phase(lds, g, S, E); }
            if (SUB & 8) phase_svt(lds, a);
            for (int r2 = 0; r2 <= ((REPSUB >> 4) & 1); ++r2) phase_lruA(lds, a, l);
        PHASE_END
        PHASE_BEGIN(4)
            phase_attention<0>(lds, a, l, need_ctx); if ((REPSUB >> 5) & 1) phase_attention<ATTVAR>(lds, a, l, need_ctx);
            for (int r2 = 0; r2 <= ((REPSUB >> 6) & 1); ++r2) phase_lruC(lds, a, need_ctx ? 0 : 16, 64);
        PHASE_END
        PHASE_BEGIN(5)
            { pg8::Gemm g{Y, (const bf16_t*)(wl + OW_BR), 3072, 1024, 1024, 1024 * 2, (long)2048 * 1024 * 2};
              pg8::Sched<3> S; S.G = G; S.c = c; S.a.init(32, 8, 4, 0); S.b.init(0, 1, 0, 0);
              pg8::EpiMerge E{MB, PROJ};
              pg8::gemm_phase(lds, g, S, E); }
            if (need_ctx) {
#pragma nounroll
              for (int kh = 0; kh < 2; ++kh) {
                pg8::Gemm g{Y + kh * 512, (const bf16_t*)(wl + OW_BR) + kh * 512, 3072, 1024, 512, 1024 * 2, (long)2048 * 1024 * 2};
                pg8::Sched<3, true> S; S.G = G; S.c = (c + 96 + kh * 128) % G; S.a.init(4, 8, 0, 0); S.b.init(0, 1, 0, 0);
                pg8::EpiPartial E{PART4 + (size_t)kh * 3 * CR * 2048};
                pg8::gemm_phase(lds, g, S, E); }
            }
        PHASE_END
        if (need_ctx) {
        PHASE_BEGIN(11)
            const int tid_ = opaque_tid();
            for (int ch = blockIdx.x * NTH + tid_; ch < CR * 256; ch += G * NTH) {
                const int R = ch >> 8, c8 = (ch & 255) * 8;
                f32x4 m0 = (f32x4){0.f, 0.f, 0.f, 0.f}, m1 = (f32x4){0.f, 0.f, 0.f, 0.f};
#pragma unroll
                for (int br = 0; br < 3; ++br) {
                    const float* p0 = PART4 + ((size_t)br * CR + R) * 2048 + c8; const float* p1 = PART4 + ((size_t)(3 + br) * CR + R) * 2048 + c8;
                    const f32x4 a0 = *(const f32x4*)p0 + *(const f32x4*)p1, a1 = *(const f32x4*)(p0 + 4) + *(const f32x4*)(p1 + 4);
                    const u32x4 gw = *(const u32x4*)(PROJ + (size_t)R * LDP + 4416 + br * 2048 + c8);
                    m0[0] += a0[0] * sigmoidf_(bflo(gw.x)); m0[1] += a0[1] * sigmoidf_(bfhi(gw.x)); m0[2] += a0[2] * sigmoidf_(bflo(gw.y)); m0[3] += a0[3] * sigmoidf_(bfhi(gw.y));
                    m1[0] += a1[0] * sigmoidf_(bflo(gw.z)); m1[1] += a1[1] * sigmoidf_(bfhi(gw.z)); m1[2] += a1[2] * sigmoidf_(bflo(gw.w)); m1[3] += a1[3] * sigmoidf_(bfhi(gw.w));
                }
                *(u32x4*)(MB + (size_t)R * 2048 + c8) = pg8::pack8(m0, m1);
            }
        PHASE_END
        }
        PHASE_BEGIN(6)
            { pg8::Gemm g{MB, (const bf16_t*)(wl + OW_OUT), 2048, 2048, 2048, 0, 0};
              pg8::Sched<1> S; S.G = G; S.c = c; S.a.init(32, 8, 4, 0); S.b.init(0, 1, 0, 0);
              pg8::EpiRes E{XV, ADA + (size_t)l * 5 * 12288 + 4096};
              pg8::gemm_phase(lds, g, S, E); }
            if (need_ctx) {
              pg8::Gemm g{MB, (const bf16_t*)(wl + OW_OUT), 2048, 2048, 256, 256 * 2, 256 * 2};
              pg8::Sched<8, true> S; S.G = G; S.c = c; S.a.init(4, 8, 0, 0); S.b.init(0, 1, 0, 0);
              pg8::EpiPartial E{PART};
              pg8::gemm_phase(lds, g, S, E); }
        PHASE_END
        PHASE_BEGIN(7)
            phase_ln(a, need_ctx ? 0 : CR, a.in[21] + l * 2048, a.in[22] + l * 2048, ADA + (size_t)l * 5 * 12288 + 6144, nullptr, PART, need_ctx ? 8 : 0, ADA + (size_t)(l * 5 + 4) * 12288 + 4096);
        PHASE_END
        PHASE_BEGIN(8)
            pg8::Gemm g{U, (const bf16_t*)(wl + OW_F1), 2048, 2048, 2048, 0, 0};
            pg8::Sched<1> S; S.G = G; S.c = c; S.a.init(nMl, 44, pm_lo, 0); S.b.init(0, 1, 0, 0);
            pg8::EpiSwiglu E{H};
            pg8::gemm_phase(lds, g, S, E);
        PHASE_END
        PHASE_BEGIN(9)
            { pg8::Gemm g{H, (const bf16_t*)(wl + OW_F2), FF, FF, FF, 0, 0};
              pg8::Sched<1> S; S.G = G; S.c = c; S.a.init(32, 8, 4, 0); S.b.init(0, 1, 0, 0);
              pg8::EpiRes E{XV, ADA + (size_t)l * 5 * 12288 + 10240};
              pg8::gemm_phase(lds, g, S, E); }
            if (need_ctx) {
              pg8::Gemm g{H, (const bf16_t*)(wl + OW_F2), FF, FF, 1408, 1408 * 2, 1408 * 2};
              pg8::Sched<4, true> S; S.G = G; S.c = c; S.a.init(4, 8, 0, 0); S.b.init(0, 1, 0, 0);
              pg8::EpiPartial E{PART};
              pg8::gemm_phase(lds, g, S, E); }
        PHASE_END
        PHASE_BEGIN(10)
            if (need_ctx) phase_ln(a, 0, a.in[25] + l * 2048, a.in[26] + l * 2048, ADA + (size_t)(l + 1) * 5 * 12288, nullptr, PART, 4, ADA + (size_t)(l * 5 + 4) * 12288 + 10240);
            else phase_ln(a, CR, a.in[25] + l * 2048, a.in[26] + l * 2048, nullptr, a.out);
        PHASE_END
    }
#undef PHASE_BEGIN
#undef PHASE_END
}

constexpr int N_PHASES = 2 + 2 * 9 + 1;

extern "C" void kernel_launch(void* const* d_in, const int* in_sizes, int n_in, void* d_out, int out_size, void* d_ws, size_t ws_size, hipStream_t stream) {
    static int grid = 0;
    if (grid == 0) {
        if (n_in != 27 || ws_size < WS_END) { fprintf(stderr, "kernel_launch: unexpected n_in %d or ws_size %zu (< %zu)\n", n_in, ws_size, (size_t)WS_END); grid = -1; return; }
        int dev = 0, cus = 0, per_cu = 0;
        hipGetDevice(&dev);
        hipDeviceGetAttribute(&cus, hipDeviceAttributeMultiprocessorCount, dev);
        hipFuncSetAttribute((const void*)mega, hipFuncAttributeMaxDynamicSharedMemorySize, LDS_BYTES);
        hipOccupancyMaxActiveBlocksPerMultiprocessor(&per_cu, (const void*)mega, NTH, LDS_BYTES);
        if (per_cu < 1) per_cu = 1;
        grid = cus * 1;
        (void)hipGetLastError();
    }
    if (grid < 0) return;
    (void)hipMemsetAsync((unsigned char*)d_ws + WS_BAR, 0, 16384, stream);
    Args a{};
    for (int i = 0; i < 27; ++i) a.in[i] = (const float*)d_in[i];
    a.out = (float*)d_out; a.ws = (unsigned char*)d_ws; a.ph_lo = 0; a.ph_hi = N_PHASES;
    void* args[] = {&a};
    hipError_t e = hipLaunchCooperativeKernel((const void*)mega, dim3(grid), dim3(NTH), args, LDS_BYTES, stream);
    if (e != hipSuccess) fprintf(stderr, "cooperative launch failed: %s (grid %d)\n", hipGetErrorString(e), grid);
}
```

```cpp
#include <hip/hip_runtime.h>
#include <hip/hip_cooperative_groups.h>
#include <cstdio>
#include <cstdint>
namespace cg = cooperative_groups;

#define LAS __attribute__((address_space(3)))
typedef unsigned short bf16_t;
typedef short bf16x8 __attribute__((ext_vector_type(8)));
typedef float f32x4 __attribute__((ext_vector_type(4)));
typedef float f32x2 __attribute__((ext_vector_type(2)));
typedef unsigned u32x4 __attribute__((ext_vector_type(4)));
typedef unsigned u32x2 __attribute__((ext_vector_type(2)));

constexpr int DM = 2048, NBATCH = 4, SEQ = 2048, CTXL = 256;
constexpr int CR = NBATCH * CTXL;
constexpr int MR = CR + NBATCH * SEQ;
constexpr int INC = 10560, LDP = 10752;
constexpr int FF = 5632;
constexpr int NTH = 512;
constexpr float ALPHA = 1.41421356237f;
constexpr float LOG2E = 1.44269504089f;

constexpr size_t SZ_WIN = (size_t)LDP * 2048 * 2, SZ_WQ = (size_t)1536 * 512 * 2, SZ_WK = (size_t)1024 * 256 * 2, SZ_WV = SZ_WK;
constexpr size_t SZ_WLRU = (size_t)2 * 2 * 8 * 128 * 128 * 2, SZ_WBR = (size_t)3 * 2048 * 1024 * 2, SZ_WOUT = (size_t)2048 * 2048 * 2;
constexpr size_t SZ_WF1 = (size_t)11264 * 2048 * 2, SZ_WF2 = (size_t)2048 * 5632 * 2;
constexpr size_t OW_IN = 0, OW_Q = OW_IN + SZ_WIN, OW_K = OW_Q + SZ_WQ, OW_V = OW_K + SZ_WK, OW_LRU = OW_V + SZ_WV, OW_BR = OW_LRU + SZ_WLRU,
                 OW_OUT = OW_BR + SZ_WBR, OW_F1 = OW_OUT + SZ_WOUT, OW_F2 = OW_F1 + SZ_WF1, W_LAYER = OW_F2 + SZ_WF2;
constexpr size_t WS_PROJ = 2 * W_LAYER;
constexpr size_t WS_XV = WS_PROJ + (size_t)MR * LDP * 2;
constexpr size_t WS_U = WS_XV + (size_t)MR * 2048 * 4;
constexpr size_t WS_Y = WS_U + (size_t)MR * 2048 * 2;
constexpr size_t WS_QB = WS_Y + (size_t)MR * 3072 * 2;
constexpr size_t WS_KN = WS_QB + (size_t)MR * 1536 * 2;
constexpr size_t WS_VT = WS_KN + (size_t)MR * 1024 * 2;
constexpr size_t WS_SVT = WS_VT + (size_t)MR * 1024 * 2;
constexpr size_t WS_MB = WS_SVT + (size_t)MR * 256 * 2;
constexpr size_t WS_ADA = WS_MB + (size_t)MR * 2048 * 2;
constexpr size_t WS_RMS = WS_ADA + (size_t)2 * 5 * 12288 * 4;
constexpr size_t WS_SUM = WS_RMS + (size_t)MR * 12 * 4;
constexpr size_t WS_ROPE = WS_SUM + (size_t)2 * 144 * 1024 * 8;
constexpr size_t WS_BAR = WS_ROPE + 64 * 16 * 8;
constexpr size_t WS_END = WS_BAR + 16384;

constexpr int LDS_BYTES = 131072 + 64;
#ifndef ATT_STAGGER
#define ATT_STAGGER 1
#endif

struct Args { const float* in[27]; float* out; unsigned char* ws; int ph_lo, ph_hi; };

__device__ __forceinline__ unsigned cvt_pk_bf16(float lo, float hi) { unsigned r; asm volatile("v_cvt_pk_bf16_f32 %0, %1, %2" : "=v"(r) : "v"(lo), "v"(hi)); return r; }
__device__ __forceinline__ float bflo(unsigned w) { return __uint_as_float(w << 16); }
__device__ __forceinline__ float bfhi(unsigned w) { return __uint_as_float(w & 0xffff0000u); }
__device__ __forceinline__ float bf2f(bf16_t v) { return __uint_as_float((unsigned)v << 16); }
__device__ __forceinline__ float sigmoidf_(float x) { return 1.0f / (1.0f + __expf(-x)); }
__device__ __forceinline__ float wave_sum(float v) {
#pragma unroll
    for (int o = 32; o >= 1; o >>= 1) v += __shfl_xor(v, o);
    return v;
}
__device__ __forceinline__ int opaque_tid() { int t = threadIdx.x; asm volatile("" : "+v"(t)); return t; }
__device__ __forceinline__ int ada_row(int R) { return R < CR ? 4 : (R - CR) >> 11; }

namespace pg8 {
constexpr int BM = 256, BK = 64, HALF = 128, HTB = HALF * BK * 2, STAGE_BYTES = 8 * HTB;
__device__ __forceinline__ int lds_byte(int r, int c) { const int st = (r >> 4) * 2 + (c >> 5), rr = r & 15, cc = c & 31, ob = rr * 64 + cc * 2; return st * 1024 + (ob ^ (((ob >> 9) & 1) << 5)); }
__device__ __forceinline__ void stage_rc(int b, int& R, int& C) { const int st = b / 1024, sb = b % 1024, swz = sb ^ (((sb >> 9) & 1) << 5); R = (st >> 1) * 16 + swz / 64; C = (st & 1) * 32 + (swz % 64) / 2; }
__device__ __forceinline__ int perm32(int rho) { const int n = rho >> 4, i = rho & 15; return 8 * (i >> 2) + 4 * n + (i & 3); }

struct Unit { int pm, pn, z; };
struct Gemm { const bf16_t* A; const bf16_t* Bt; int lda, ldb, K; long zA, zB; };

struct Order {
    int nM, nN, pm0, pn0, nwg;
    __device__ __forceinline__ void init(int nM_, int nN_, int pm0_, int pn0_) { nM = nM_; nN = nN_; pm0 = pm0_; pn0 = pn0_; nwg = nM_ * nN_; }
    __device__ __forceinline__ void map(int L, Unit& u) const {
        int wgid = L; { const int q = nwg / 8, r = nwg % 8, xcd = wgid % 8, off = wgid / 8; wgid = (xcd < r ? xcd * (q + 1) : r * (q + 1) + (xcd - r) * q) + off; }
        const int nig = 8 * nN, gid = wgid / nig, fm = gid * 8, gsz = (nM - fm) < 8 ? (nM - fm) : 8;
        u.pm = pm0 + fm + ((wgid % nig) % gsz); u.pn = pn0 + (wgid % nig) / gsz;
    }
};
template <int ZREP, bool ZSPREAD = false> struct Sched {
    Order a, b; int G, c;
    __device__ __forceinline__ bool next(int i, Unit& u) const {
        if (ZSPREAD) { const int L = i * G + c; if (L >= a.nwg * ZREP) return false; const int t = L / ZREP; u.z = L - t * ZREP; a.map(t, u); return true; }
        const int rnd = i / ZREP; u.z = i - rnd * ZREP; int L = rnd * G + c;
        if (L < a.nwg) { a.map(L, u); return true; }
        L -= a.nwg; if (L < b.nwg) { b.map(L, u); return true; }
        return false;
    }
};

template <class Epi, class SchedT>
__device__ __forceinline__ void gemm_phase(LAS unsigned char* lds, const Gemm g, const SchedT& S, const Epi& E) {
    const int tid = opaque_tid(), wid = __builtin_amdgcn_readfirstlane(tid >> 6), lane = tid & 63, wr = wid >> 2, wc = wid & 3, fr = lane & 15, fq = lane >> 4;
    int K = g.K; asm volatile("" : "+s"(K)); const int nt = K / BK;
    unsigned voffA[2], voffB[2];
#pragma unroll
    for (int i = 0; i < 2; ++i) { int R, C; stage_rc(tid * 16 + i * 8192, R, C); const int Rb = Epi::PERM ? ((R & ~31) + perm32(R & 31)) : R;
        voffA[i] = (unsigned)(R * g.lda + C) * 2u; voffB[i] = (unsigned)(Rb * g.ldb + C) * 2u; }
    const size_t kstep = (size_t)(BK * 2);
    const size_t hstepA = (size_t)HALF * g.lda * 2, hstepB = (size_t)HALF * g.ldb * 2;
    const size_t tstepA = 2 * hstepA, tstepB = 2 * hstepB;
    const unsigned ldsw = (unsigned)wid * 1024u;
    const int aoff = lds_byte(wr * 64 + fr, fq * 8), boff = lds_byte(wc * 32 + fr, fq * 8);
#define PG8_SA(b, h) (((b) * 2 + (h)) * HTB)
#define PG8_SB(b, h) ((4 + (b) * 2 + (h)) * HTB)
#define PG8_STAGE(bufoff, gbase, voff) do { _Pragma("unroll") for (int _i = 0; _i < 2; ++_i) \
        __builtin_amdgcn_global_load_lds((const unsigned*)((const char*)(gbase) + (voff)[_i]), (LAS unsigned*)(lds + (bufoff) + ldsw + _i * 8192), 16, 0, 0); } while (0)
#define PG8_LDA(dst, b, h) do { _Pragma("unroll") for (int m = 0; m < 4; ++m) _Pragma("unroll") for (int k = 0; k < 2; ++k) dst[m][k] = *(const LAS bf16x8*)(lds + PG8_SA(b, h) + aoff + m * 2048 + k * 1024); } while (0)
#define PG8_LDB(dst, b, h) do { _Pragma("unroll") for (int n = 0; n < 2; ++n) _Pragma("unroll") for (int k = 0; k < 2; ++k) dst[n][k] = *(const LAS bf16x8*)(lds + PG8_SB(b, h) + boff + n * 2048 + k * 1024); } while (0)
#define PG8_MMA(ai, bj, At, Bt) do { __builtin_amdgcn_s_setprio(1); _Pragma("unroll") for (int m = 0; m < 4; ++m) _Pragma("unroll") for (int n = 0; n < 2; ++n) _Pragma("unroll") for (int k = 0; k < 2; ++k) \
        acc[ai][bj][m][n] = __builtin_amdgcn_mfma_f32_16x16x32_bf16(Bt[n][k], At[m][k], acc[ai][bj][m][n], 0, 0, 0); __builtin_amdgcn_s_setprio(0); } while (0)
#define PG8_WAIT_V(n) asm volatile("s_waitcnt vmcnt(" #n ")" ::: "memory")
#define PG8_WAIT_L(n) asm volatile("s_waitcnt lgkmcnt(" #n ")" ::: "memory")
#define PG8_BAR __builtin_amdgcn_s_barrier()
#define PG8_SCHED __builtin_amdgcn_sched_barrier(0)
    Unit cur, nxt; int ui = 0;
    if (!S.next(0, cur)) return;
    f32x4 acc[2][2][4][2];
#pragma unroll
    for (int a = 0; a < 2; ++a)
#pragma unroll
        for (int b = 0; b < 2; ++b)
#pragma unroll
            for (int m = 0; m < 4; ++m)
#pragma unroll
                for (int n = 0; n < 2; ++n) acc[a][b][m][n] = (f32x4){0.f, 0.f, 0.f, 0.f};
    bf16x8 At[4][2], B0[2][2], B1[2][2];
    const char* cA = (const char*)g.A + (long)cur.z * g.zA + (size_t)cur.pm * tstepA; const char* cB = (const char*)g.Bt + (long)cur.z * g.zB + (size_t)cur.pn * tstepB;
    PG8_STAGE(PG8_SB(0, 0), cB, voffB); PG8_STAGE(PG8_SB(0, 1), cB + hstepB, voffB); PG8_STAGE(PG8_SA(0, 0), cA, voffA); PG8_STAGE(PG8_SA(0, 1), cA + hstepA, voffA);
    if (wr == 1) PG8_BAR;
    PG8_WAIT_V(2); PG8_BAR;
    PG8_STAGE(PG8_SB(1, 0), cB + kstep, voffB); PG8_STAGE(PG8_SA(1, 0), cA + kstep, voffA); PG8_STAGE(PG8_SB(1, 1), cB + hstepB + kstep, voffB);
    PG8_WAIT_V(6); PG8_BAR;
    for (;;) {
        const bool has_next = S.next(ui + 1, nxt);
        const char* nA = has_next ? (const char*)g.A + (long)nxt.z * g.zA + (size_t)nxt.pm * tstepA : cA; const char* nB = has_next ? (const char*)g.Bt + (long)nxt.z * g.zB + (size_t)nxt.pn * tstepB : cB;
        for (int t = 0; t < nt; t += 2) {
            const bool last = (t == nt - 2);
            const char* a1 = cA + (size_t)(t + 1) * kstep;
            const char* a2 = last ? nA : cA + (size_t)(t + 2) * kstep; const char* b2 = last ? nB : cB + (size_t)(t + 2) * kstep;
            const char* a3 = a2 + kstep; const char* b3 = b2 + kstep;
            PG8_LDB(B0, 0, 0); PG8_LDB(B1, 0, 1); PG8_SCHED; PG8_LDA(At, 0, 0); PG8_STAGE(PG8_SA(1, 1), a1 + hstepA, voffA);
            PG8_WAIT_V(8); PG8_WAIT_L(0); PG8_BAR; PG8_MMA(0, 0, At, B0); PG8_MMA(0, 1, At, B1); PG8_BAR; PG8_SCHED;
            PG8_LDA(At, 0, 1); PG8_STAGE(PG8_SB(0, 0), b2, voffB); PG8_STAGE(PG8_SB(0, 1), b2 + hstepB, voffB); PG8_STAGE(PG8_SA(0, 0), a2, voffA);
            PG8_WAIT_V(8); PG8_WAIT_L(0); PG8_BAR; PG8_MMA(1, 0, At, B0); PG8_MMA(1, 1, At, B1); PG8_BAR; PG8_SCHED;
            PG8_LDB(B0, 1, 0); PG8_LDB(B1, 1, 1); PG8_SCHED; PG8_LDA(At, 1, 0); PG8_STAGE(PG8_SA(0, 1), a2 + hstepA, voffA);
            PG8_WAIT_V(8); PG8_WAIT_L(0); PG8_BAR; PG8_MMA(0, 0, At, B0); PG8_MMA(0, 1, At, B1); PG8_BAR; PG8_SCHED;
            PG8_LDA(At, 1, 1); PG8_STAGE(PG8_SB(1, 0), b3, voffB); PG8_STAGE(PG8_SB(1, 1), b3 + hstepB, voffB); PG8_STAGE(PG8_SA(1, 0), a3, voffA);
            PG8_WAIT_V(8); PG8_WAIT_L(0); PG8_BAR; PG8_MMA(1, 0, At, B0); PG8_MMA(1, 1, At, B1); PG8_BAR; PG8_SCHED;
        }
        if (wr == 0) PG8_BAR;
        E(acc, cur, wr, wc, fr, fq);
        if (!has_next) break;
#pragma unroll
        for (int a = 0; a < 2; ++a)
#pragma unroll
            for (int b = 0; b < 2; ++b)
#pragma unroll
                for (int m = 0; m < 4; ++m)
#pragma unroll
                    for (int n = 0; n < 2; ++n) acc[a][b][m][n] = (f32x4){0.f, 0.f, 0.f, 0.f};
        cur = nxt; cA = nA; cB = nB; ++ui;
        if (wr == 1) PG8_BAR;
    }
    PG8_WAIT_V(0);
    PG8_BAR;
#undef PG8_SA
#undef PG8_SB
#undef PG8_STAGE
#undef PG8_LDA
#undef PG8_LDB
#undef PG8_MMA
#undef PG8_WAIT_V
#undef PG8_WAIT_L
#undef PG8_BAR
#undef PG8_SCHED
}

typedef f32x4 AccT[2][2][4][2];

__device__ __forceinline__ void rope4(f32x4& v0, f32x4& v1, const float* rope, int pos, int fq) {
    const f32x4* rp = (const f32x4*)(rope + (pos * 16 + 4 * fq) * 2);
    const f32x4 c01 = rp[0], c23 = rp[1];
    f32x4 a = v0, b = v1;
    v0[0] = a[0] * c01[0] - b[0] * c01[1]; v1[0] = a[0] * c01[1] + b[0] * c01[0];
    v0[1] = a[1] * c01[2] - b[1] * c01[3]; v1[1] = a[1] * c01[3] + b[1] * c01[2];
    v0[2] = a[2] * c23[0] - b[2] * c23[1]; v1[2] = a[2] * c23[1] + b[2] * c23[0];
    v0[3] = a[3] * c23[2] - b[3] * c23[3]; v1[3] = a[3] * c23[3] + b[3] * c23[2];
}
__device__ __forceinline__ u32x2 pack4(f32x4 v) { u32x2 w; w.x = cvt_pk_bf16(v[0], v[1]); w.y = cvt_pk_bf16(v[2], v[3]); return w; }
__device__ __forceinline__ u32x4 pack8(f32x4 v0, f32x4 v1) { u32x4 w; w.x = cvt_pk_bf16(v0[0], v0[1]); w.y = cvt_pk_bf16(v0[2], v0[3]); w.z = cvt_pk_bf16(v1[0], v1[1]); w.w = cvt_pk_bf16(v1[2], v1[3]); return w; }

struct EpiProj {
    static constexpr bool PERM = false;
    bf16_t* P; const float* rope; float* rmsp;
    __device__ __forceinline__ void operator()(const AccT& acc, const Unit& u, int wr, int wc, int fr, int fq) const {
        const int row0 = u.pm * 256 + wr * 64 + fr;
        const bool lat = u.pm >= 4;
        const bool rms = (u.pn >= 8 && u.pn <= 10);
#pragma unroll
        for (int ai = 0; ai < 2; ++ai)
#pragma unroll
            for (int m = 0; m < 4; ++m) {
                const int R = row0 + ai * 128 + m * 16;
                bf16_t* rowp = P + (size_t)R * LDP + u.pn * 256 + wc * 32 + 4 * fq;
                float ss = 0.f;
#pragma unroll
                for (int bj = 0; bj < 2; ++bj) {
                    const int col32 = u.pn * 256 + bj * 128 + wc * 32;
                    f32x4 v0 = acc[ai][bj][m][0], v1 = acc[ai][bj][m][1];
                    ss += v0[0] * v0[0] + v0[1] * v0[1] + v0[2] * v0[2] + v0[3] * v0[3] + v1[0] * v1[0] + v1[1] * v1[1] + v1[2] * v1[2] + v1[3] * v1[3];
                    if (lat && col32 >= 2816 && col32 < 4160) {
                        const int t = (R - CR) & 2047; const int pos = (wc & 1) ? (t & 63) : (t >> 6);
                        rope4(v0, v1, rope, pos, fq);
                    }
                    *(u32x2*)(rowp + bj * 128) = pack4(v0);
                    *(u32x2*)(rowp + bj * 128 + 16) = pack4(v1);
                }
                if (rms) { ss += __shfl_xor(ss, 16); ss += __shfl_xor(ss, 32); if (fq == 0) rmsp[(size_t)R * 12 + (u.pn - 8) * 4 + wc] = ss; }
            }
    }
};

struct EpiQ {
    static constexpr bool PERM = false;
    bf16_t* Q; const float* rope; const float* rmsp;
    __device__ __forceinline__ void operator()(const AccT& acc, const Unit& u, int wr, int wc, int fr, int fq) const {
        const int row0 = u.pm * 256 + wr * 64 + fr;
        const bool lat = u.pm >= 4;
#pragma unroll
        for (int ai = 0; ai < 2; ++ai)
#pragma unroll
            for (int m = 0; m < 4; ++m) {
                const int R = row0 + ai * 128 + m * 16;
                const f32x4 p0 = *(const f32x4*)(rmsp + (size_t)R * 12), p1 = *(const f32x4*)(rmsp + (size_t)R * 12 + 4);
                const float rs = rsqrtf(((p0[0] + p0[1]) + (p0[2] + p0[3]) + (p1[0] + p1[1]) + (p1[2] + p1[3])) * (1.0f / 512.0f) + 1e-6f);
#pragma unroll
                for (int bj = 0; bj < 2; ++bj) {
                    f32x4 v0 = acc[ai][bj][m][0] * rs, v1 = acc[ai][bj][m][1] * rs;
                    int dcol;
                    if (u.pn < 4) dcol = (2 * u.pn + bj) * 192 + wc * 32 + 4 * fq;
                    else {
                        const int c = bj * 128 + wc * 32;
                        dcol = ((u.pn - 4) * 4 + (c >> 6)) * 192 + 128 + (c & 63) + 4 * fq;
                        if (lat) { const int t = (R - CR) & 2047; const int pos = (wc & 1) ? (t & 63) : (t >> 6); rope4(v0, v1, rope, pos, fq); }
                    }
                    bf16_t* dst = Q + (size_t)R * 1536 + dcol;
                    *(u32x2*)dst = pack4(v0); *(u32x2*)(dst + 16) = pack4(v1);
                }
            }
    }
};

struct EpiKN {
    static constexpr bool PERM = true;
    bf16_t* KN; const float* rmsp;
    __device__ __forceinline__ void operator()(const AccT& acc, const Unit& u, int wr, int wc, int fr, int fq) const {
        const int row0 = u.pm * 256 + wr * 64 + fr;
#pragma unroll
        for (int ai = 0; ai < 2; ++ai)
#pragma unroll
            for (int m = 0; m < 4; ++m) {
                const int R = row0 + ai * 128 + m * 16;
                const f32x4 p = *(const f32x4*)(rmsp + (size_t)R * 12 + 8);
                const float rs = rsqrtf(((p[0] + p[1]) + (p[2] + p[3])) * (1.0f / 256.0f) + 1e-6f);
#pragma unroll
                for (int bj = 0; bj < 2; ++bj)
                    *(u32x4*)(KN + (size_t)R * 1024 + u.pn * 256 + bj * 128 + wc * 32 + 8 * fq) = pack8(acc[ai][bj][m][0] * rs, acc[ai][bj][m][1] * rs);
            }
    }
};

struct EpiVT {
    static constexpr bool PERM = true;
    bf16_t* VT; const float* rmsp;
    __device__ __forceinline__ void operator()(const AccT& acc, const Unit& u, int wr, int wc, int fr, int fq) const {
        const int row0 = u.pm * 256 + wr * 64 + fr;
#pragma unroll
        for (int bj = 0; bj < 2; ++bj) {
            const int tok0 = u.pn * 256 + bj * 128 + wc * 32 + 8 * fq;
            float rs[8];
#pragma unroll
            for (int e = 0; e < 8; ++e) { const f32x4 p = *(const f32x4*)(rmsp + (size_t)(tok0 + e) * 12 + 8); rs[e] = rsqrtf(((p[0] + p[1]) + (p[2] + p[3])) * (1.0f / 256.0f) + 1e-6f); }
#pragma unroll
            for (int ai = 0; ai < 2; ++ai)
#pragma unroll
                for (int m = 0; m < 4; ++m) {
                    const int vr = row0 + ai * 128 + m * 16;
                    f32x4 v0 = acc[ai][bj][m][0], v1 = acc[ai][bj][m][1];
                    v0[0] *= rs[0]; v0[1] *= rs[1]; v0[2] *= rs[2]; v0[3] *= rs[3]; v1[0] *= rs[4]; v1[1] *= rs[5]; v1[2] *= rs[6]; v1[3] *= rs[7];
                    *(u32x4*)(VT + (size_t)vr * MR + tok0) = pack8(v0, v1);
                }
        }
    }
};

struct EpiMerge {
    static constexpr bool PERM = true;
    bf16_t* MB; const bf16_t* P;
    __device__ __forceinline__ void operator()(const AccT& acc, const Unit& u, int wr, int wc, int fr, int fq) const {
        const int row0 = u.pm * 256 + wr * 64 + fr;
#pragma unroll
        for (int ai = 0; ai < 2; ++ai)
#pragma unroll
            for (int m = 0; m < 4; ++m) {
                const int R = row0 + ai * 128 + m * 16;
#pragma unroll
                for (int bj = 0; bj < 2; ++bj) {
                    const int col = u.pn * 256 + bj * 128 + wc * 32 + 8 * fq;
                    const u32x4 gw = *(const u32x4*)(P + (size_t)R * LDP + 4416 + u.z * 2048 + col);
                    f32x4 v0 = acc[ai][bj][m][0], v1 = acc[ai][bj][m][1];
                    v0[0] *= sigmoidf_(bflo(gw.x)); v0[1] *= sigmoidf_(bfhi(gw.x)); v0[2] *= sigmoidf_(bflo(gw.y)); v0[3] *= sigmoidf_(bfhi(gw.y));
                    v1[0] *= sigmoidf_(bflo(gw.z)); v1[1] *= sigmoidf_(bfhi(gw.z)); v1[2] *= sigmoidf_(bflo(gw.w)); v1[3] *= sigmoidf_(bfhi(gw.w));
                    bf16_t* dst = MB + (size_t)R * 2048 + col;
                    if (u.z > 0) { const u32x4 mw = *(const u32x4*)dst;
                        v0[0] += bflo(mw.x); v0[1] += bfhi(mw.x); v0[2] += bflo(mw.y); v0[3] += bfhi(mw.y); v1[0] += bflo(mw.z); v1[1] += bfhi(mw.z); v1[2] += bflo(mw.w); v1[3] += bfhi(mw.w); }
                    *(u32x4*)dst = pack8(v0, v1);
                }
            }
    }
};

struct EpiRes {
    static constexpr bool PERM = false;
    float* XV; const float* gate;
    __device__ __forceinline__ void operator()(const AccT& acc, const Unit& u, int wr, int wc, int fr, int fq) const {
        const int row0 = u.pm * 256 + wr * 64 + fr, col0 = u.pn * 256 + wc * 32 + 4 * fq;
        const float* gp = gate + (size_t)(u.pm < 4 ? 4 : (u.pm - 4) >> 3) * 12288 + col0;
        f32x4 gv[2][2];
#pragma unroll
        for (int bj = 0; bj < 2; ++bj)
#pragma unroll
            for (int n = 0; n < 2; ++n) gv[bj][n] = *(const f32x4*)(gp + bj * 128 + n * 16);
#pragma unroll
        for (int ai = 0; ai < 2; ++ai)
#pragma unroll
            for (int m = 0; m < 4; ++m) { float* rowp = XV + (size_t)(row0 + ai * 128 + m * 16) * 2048 + col0;
#pragma unroll
                for (int bj = 0; bj < 2; ++bj)
#pragma unroll
                    for (int n = 0; n < 2; ++n) { f32x4* p = (f32x4*)(rowp + bj * 128 + n * 16); *p = *p * ALPHA + gv[bj][n] * acc[ai][bj][m][n]; } }
    }
};

struct EpiPartial {
    static constexpr bool PERM = false;
    float* PART;
    __device__ __forceinline__ void operator()(const AccT& acc, const Unit& u, int wr, int wc, int fr, int fq) const {
        const int row0 = u.pm * 256 + wr * 64 + fr, col0 = u.pn * 256 + wc * 32 + 4 * fq;
#pragma unroll
        for (int ai = 0; ai < 2; ++ai)
#pragma unroll
            for (int m = 0; m < 4; ++m) { float* rowp = PART + ((size_t)u.z * CR + row0 + ai * 128 + m * 16) * 2048 + col0;
#pragma unroll
                for (int bj = 0; bj < 2; ++bj)
#pragma unroll
                    for (int n = 0; n < 2; ++n) *(f32x4*)(rowp + bj * 128 + n * 16) = acc[ai][bj][m][n]; }
    }
};

struct EpiSwiglu {
    static constexpr bool PERM = true;
    bf16_t* H;
    __device__ __forceinline__ void operator()(const AccT& acc, const Unit& u, int wr, int wc, int fr, int fq) const {
        const int row0 = u.pm * 256 + wr * 64 + fr;
#pragma unroll
        for (int ai = 0; ai < 2; ++ai)
#pragma unroll
            for (int m = 0; m < 4; ++m) {
                f32x4 o[2];
#pragma unroll
                for (int n = 0; n < 2; ++n)
#pragma unroll
                    for (int j = 0; j < 4; ++j) { const float gt = acc[ai][0][m][n][j]; o[n][j] = gt * sigmoidf_(gt) * acc[ai][1][m][n][j]; }
                *(u32x4*)(H + (size_t)(row0 + ai * 128 + m * 16) * FF + u.pn * 128 + wc * 32 + 8 * fq) = pack8(o[0], o[1]);
            }
    }
};
}

__device__ __forceinline__ int colmap(int kind, int n0, int nsrc) {
    switch (kind) {
        case 0: return n0 < nsrc ? n0 : -1;
        case 1: { const int tile = n0 >> 8, rem = n0 & 255; return (rem >> 7) * FF + tile * 128 + (rem & 127); }
        case 2: if (n0 < 1024) return (n0 >> 7) * 192 + (n0 & 127); else { const int r = n0 - 1024; return (r >> 6) * 192 + 128 + (r & 63); }
        case 3: return (n0 >> 7) * 256 + (n0 & 127);
        default: return (n0 >> 7) * 256 + 128 + (n0 & 127);
    }
}
__device__ __forceinline__ void conv_job(LAS unsigned char* lds, int& tbase, const float* src, int ldsrc, int nsrc, int K, int Np, int kind, const float* kscale, bf16_t* dst, float s_all = 1.0f, int cs_lo = 0, int cs_hi = 0, float s_rng = 1.0f) {
    const int tid = opaque_tid(), wave = tid >> 6, lane = tid & 63;
    LAS bf16_t* T = (LAS bf16_t*)(lds + wave * 8704);
    const int GW = gridDim.x * 8, gw = blockIdx.x * 8 + wave;
    const int tk = K >> 6, ntile = tk * (Np >> 6);
    int first = gw - (tbase % GW); if (first < 0) first += GW;
    for (int t = first; t < ntile; t += GW) {
        const int n0 = (t / tk) << 6, k0 = (t % tk) << 6;
        const int sc = colmap(kind, n0, nsrc);
        f32x4 v[16];
        if (sc >= 0) {
            const float* sp = src + (size_t)(k0 + (lane >> 4)) * ldsrc + sc + (lane & 15) * 4;
#pragma unroll
            for (int r = 0; r < 16; ++r) v[r] = __builtin_nontemporal_load((const f32x4*)(sp + (size_t)(r * 4) * ldsrc));
            const float sf = (n0 >= cs_lo && n0 < cs_hi) ? s_rng : s_all;
            if (kscale) {
#pragma unroll
                for (int r = 0; r < 16; ++r) v[r] = v[r] * (kscale[k0 + r * 4 + (lane >> 4)] * sf);
            } else if (sf != 1.0f) {
#pragma unroll
                for (int r = 0; r < 16; ++r) v[r] = v[r] * sf;
            }
        } else {
#pragma unroll
            for (int r = 0; r < 16; ++r) v[r] = (f32x4){0.f, 0.f, 0.f, 0.f};
        }
        asm volatile("" ::: "memory");
#pragma unroll
        for (int r = 0; r < 16; ++r) *(LAS u32x2*)(T + (r * 4 + (lane >> 4)) * 68 + (lane & 15) * 4) = pg8::pack4(v[r]);
        asm volatile("s_waitcnt lgkmcnt(0)" ::: "memory");
#pragma unroll
        for (int p = 0; p < 8; ++p) {
            const int nr = p * 8 + (lane >> 3), kc = (lane & 7) * 8;
            u32x4 w;
            w.x = (unsigned)T[(kc + 0) * 68 + nr] | ((unsigned)T[(kc + 1) * 68 + nr] << 16); w.y = (unsigned)T[(kc + 2) * 68 + nr] | ((unsigned)T[(kc + 3) * 68 + nr] << 16);
            w.z = (unsigned)T[(kc + 4) * 68 + nr] | ((unsigned)T[(kc + 5) * 68 + nr] << 16); w.w = (unsigned)T[(kc + 6) * 68 + nr] | ((unsigned)T[(kc + 7) * 68 + nr] << 16);
            *(u32x4*)(dst + (size_t)(n0 + nr) * K + k0 + kc) = w;
        }
        asm volatile("s_waitcnt lgkmcnt(0)" ::: "memory");
    }
    tbase += ntile;
}

__device__ __forceinline__ void phase_convert(LAS unsigned char* lds, const Args& a) {
    LAS unsigned char* T = lds;
    int tbase = 0;
#pragma nounroll
    for (int l = 0; l < 2; ++l) {
        unsigned char* wl = a.ws + (size_t)l * W_LAYER;
        conv_job(T, tbase, a.in[6] + (size_t)l * 2048 * INC, INC, INC, 2048, LDP, 0, nullptr, (bf16_t*)(wl + OW_IN), 1.0f, 2880, 3904, 0.125f * LOG2E);
        conv_job(T, tbase, a.in[15] + (size_t)l * 512 * 1536, 1536, 1536, 512, 1536, 2, a.in[14] + l * 512, (bf16_t*)(wl + OW_Q), 0.07216878364870322f * LOG2E);
        conv_job(T, tbase, a.in[17] + (size_t)l * 256 * 2048, 2048, 2048, 256, 1024, 3, a.in[16] + l * 256, (bf16_t*)(wl + OW_K));
        conv_job(T, tbase, a.in[17] + (size_t)l * 256 * 2048, 2048, 2048, 256, 1024, 4, a.in[16] + l * 256, (bf16_t*)(wl + OW_V));
#pragma nounroll
        for (int i = 0; i < 32; ++i) {
            const int d = i >> 4, ri = (i >> 3) & 1, n = i & 7;
            const float* src = (ri ? a.in[11] : a.in[9]) + ((size_t)(l * 2 + d) * 8 + n) * 128 * 128;
            conv_job(T, tbase, src, 128, 128, 128, 128, 0, nullptr, (bf16_t*)(wl + OW_LRU) + (size_t)i * 128 * 128);
        }
#pragma nounroll
        for (int z = 0; z < 3; ++z)
            conv_job(T, tbase, a.in[19] + ((size_t)l * 3 + z) * 1024 * 2048, 2048, 2048, 1024, 2048, 0, nullptr, (bf16_t*)(wl + OW_BR) + (size_t)z * 2048 * 1024);
        conv_job(T, tbase, a.in[20] + (size_t)l * 2048 * 2048, 2048, 2048, 2048, 2048, 0, nullptr, (bf16_t*)(wl + OW_OUT));
        conv_job(T, tbase, a.in[23] + (size_t)l * 2048 * 11264, 11264, 11264, 2048, 11264, 1, nullptr, (bf16_t*)(wl + OW_F1));
        conv_job(T, tbase, a.in[24] + (size_t)l * FF * 2048, 2048, 2048, FF, 2048, 0, nullptr, (bf16_t*)(wl + OW_F2));
    }
    __syncthreads();
}

__device__ __forceinline__ void phase_ada(LAS unsigned char* lds, const Args& a) {
    LAS float* act = (LAS float*)lds;
    LAS float* red = act + 5 * 2048;
    const int tid = opaque_tid(), G = gridDim.x;
    float* ada = (float*)(a.ws + WS_ADA);
    __syncthreads();
    for (int i = tid; i < 5 * 2048; i += NTH) { const int r = i >> 11, k = i & 2047; const float v = r < 4 ? a.in[1][r * 2048 + k] : a.in[3][k]; act[i] = v / (1.0f + __expf(-v)); }
    __syncthreads();
    const int cgp = tid & 7, kg = tid >> 3;
    for (int unit = blockIdx.x; unit < 2 * 384; unit += G) {
        const int l = unit / 384, n0 = (unit % 384) * 32;
        const float* w = a.in[4] + (size_t)l * 2048 * 12288 + n0 + cgp * 4;
        f32x4 acc[5];
#pragma unroll
        for (int r = 0; r < 5; ++r) acc[r] = (f32x4){0.f, 0.f, 0.f, 0.f};
#pragma unroll 8
        for (int kk = 0; kk < 32; ++kk) {
            const int k = kg * 32 + kk;
            const f32x4 wv = __builtin_nontemporal_load((const f32x4*)(w + (size_t)k * 12288));
#pragma unroll
            for (int r = 0; r < 5; ++r) acc[r] += wv * act[r * 2048 + k];
        }
#pragma unroll
        for (int r = 0; r < 5; ++r)
#pragma unroll
            for (int j = 0; j < 4; ++j) red[(kg * 5 + r) * 32 + cgp * 4 + j] = acc[r][j];
        __syncthreads();
        if (tid < 160) { const int r = tid >> 5, col = tid & 31; float s = 0.f;
            for (int q = 0; q < 64; ++q) s += red[(q * 5 + r) * 32 + col];
            ada[(size_t)(l * 5 + r) * 12288 + n0 + col] = s + a.in[5][l * 12288 + n0 + col]; }
        __syncthreads();
    }
}

__device__ __forceinline__ void phase_rope_table(const Args& a) {
    if (blockIdx.x != 0) return;
    float* tab = (float*)(a.ws + WS_ROPE);
    for (int e = threadIdx.x; e < 1024; e += NTH) {
        const int pos = e >> 4, i = e & 15;
        double inv = 1.0; for (int q = 0; q < i; ++q) inv *= 0.56234132519034908;
        const float ang = (float)pos * (float)inv;
        double x = (double)ang;
        const double kq = rint(x * 0.15915494309189535);
        x = (x - kq * 6.283185307179586) - kq * 2.4492935982947064e-16;
        const double x2 = x * x;
        double ts = x, ss = x, tc = 1.0, cs = 1.0;
        for (int q = 1; q <= 15; ++q) { ts *= -x2 / (double)((2 * q) * (2 * q + 1)); ss += ts; tc *= -x2 / (double)((2 * q - 1) * (2 * q)); cs += tc; }
        tab[e * 2] = (float)cs; tab[e * 2 + 1] = (float)ss;
    }
}

__device__ __forceinline__ void phase_init_u(const Args& a) {
    const int tid_ = opaque_tid(); const int lane = tid_ & 63, gw = blockIdx.x * 8 + (tid_ >> 6), nw = gridDim.x * 8;
    float* XV = (float*)(a.ws + WS_XV); bf16_t* U = (bf16_t*)(a.ws + WS_U);
    const float* ada = (const float*)(a.ws + WS_ADA);
    for (int R = gw; R < MR; R += nw) {
        const float* src = R < CR ? a.in[2] + (size_t)R * 2048 : a.in[0] + (size_t)(R - CR) * 2048;
        const float* ar = ada + (size_t)ada_row(R) * 12288;
#pragma unroll
        for (int i = 0; i < 8; ++i) {
            const int c = (i * 64 + lane) * 4;
            const f32x4 v = *(const f32x4*)(src + c);
            *(f32x4*)(XV + (size_t)R * 2048 + c) = v;
            const f32x4 sh = *(const f32x4*)(ar + c), sc = *(const f32x4*)(ar + 2048 + c);
            *(u32x2*)(U + (size_t)R * 2048 + c) = pg8::pack4(v * (sc + 1.0f) + sh);
        }
    }
}

__device__ __forceinline__ void phase_ln(const Args& a, int R0, const float* g, const float* b, const float* mod  , float* out, const float* part = nullptr, int npart = 0, const float* cgate = nullptr) {
    const int tid_ = opaque_tid(); const int lane = tid_ & 63, gw = blockIdx.x * 8 + (tid_ >> 6), nw = gridDim.x * 8;
    float* XV = (float*)(a.ws + WS_XV); bf16_t* U = (bf16_t*)(a.ws + WS_U);
    f32x4 vn[8];
    if (R0 + gw < MR) {
#pragma unroll
        for (int i = 0; i < 8; ++i) vn[i] = *(const f32x4*)(XV + (size_t)(R0 + gw) * 2048 + (i * 64 + lane) * 4);
    }
    for (int R = R0 + gw; R < MR; R += nw) {
        f32x4 v[8]; float s = 0.f;
#pragma unroll
        for (int i = 0; i < 8; ++i) v[i] = vn[i];
        if (R + nw < MR) {
#pragma unroll
            for (int i = 0; i < 8; ++i) vn[i] = *(const f32x4*)(XV + (size_t)(R + nw) * 2048 + (i * 64 + lane) * 4);
        }
        if (npart && R < CR) {
#pragma unroll
            for (int i = 0; i < 8; ++i) {
                const int c = (i * 64 + lane) * 4; f32x4 acc = (f32x4){0.f, 0.f, 0.f, 0.f};
                for (int z = 0; z < npart; ++z) acc += *(const f32x4*)(part + ((size_t)z * CR + R) * 2048 + c);
                v[i] = v[i] * ALPHA + *(const f32x4*)(cgate + c) * acc;
            }
        }
#pragma unroll
        for (int i = 0; i < 8; ++i) s += (v[i][0] + v[i][1]) + (v[i][2] + v[i][3]);
        const float mean = wave_sum(s) * (1.0f / 2048.0f);
        float q = 0.f;
#pragma unroll
        for (int i = 0; i < 8; ++i) { v[i] = v[i] - mean; q += (v[i][0] * v[i][0] + v[i][1] * v[i][1]) + (v[i][2] * v[i][2] + v[i][3] * v[i][3]); }
        const float rstd = rsqrtf(wave_sum(q) * (1.0f / 2048.0f) + 1e-5f);
        const float* ar = mod ? mod + (size_t)ada_row(R) * 12288 : nullptr;
#pragma unroll
        for (int i = 0; i < 8; ++i) {
            const int c = (i * 64 + lane) * 4;
            const f32x4 y = v[i] * rstd * *(const f32x4*)(g + c) + *(const f32x4*)(b + c);
            if (out) { *(f32x4*)(out + (size_t)(R - CR) * 2048 + c) = y; }
            else {
                *(f32x4*)(XV + (size_t)R * 2048 + c) = y;
                const f32x4 sh = *(const f32x4*)(ar + c), sc = *(const f32x4*)(ar + 2048 + c);
                *(u32x2*)(U + (size_t)R * 2048 + c) = pg8::pack4(y * (sc + 1.0f) + sh);
            }
        }
    }
}

__device__ __forceinline__ void phase_svt(LAS unsigned char* lds, const Args& a) {
    LAS bf16_t* T = (LAS bf16_t*)lds;
    const bf16_t* P = (const bf16_t*)(a.ws + WS_PROJ); bf16_t* SVT = (bf16_t*)(a.ws + WS_SVT);
    const int tid = opaque_tid();
    for (int tile = blockIdx.x; tile < MR / 64; tile += gridDim.x) {
        const int R0 = tile * 64;
        __syncthreads();
#pragma unroll
        for (int p = 0; p < 4; ++p) { const int idx = tid + p * NTH, tok = idx >> 5, c8 = (idx & 31) * 8;
            const u32x4 w = *(const u32x4*)(P + (size_t)(R0 + tok) * LDP + 4160 + c8);
            LAS unsigned* d = (LAS unsigned*)(T + tok * 258 + c8); d[0] = w.x; d[1] = w.y; d[2] = w.z; d[3] = w.w; }
        __syncthreads();
#pragma unroll
        for (int p = 0; p < 4; ++p) { const int idx = tid + p * NTH, vr = idx & 255, kc = (idx >> 8) * 8;
            u32x4 w;
            w.x = (unsigned)T[(kc + 0) * 258 + vr] | ((unsigned)T[(kc + 1) * 258 + vr] << 16); w.y = (unsigned)T[(kc + 2) * 258 + vr] | ((unsigned)T[(kc + 3) * 258 + vr] << 16);
            w.z = (unsigned)T[(kc + 4) * 258 + vr] | ((unsigned)T[(kc + 5) * 258 + vr] << 16); w.w = (unsigned)T[(kc + 6) * 258 + vr] | ((unsigned)T[(kc + 7) * 258 + vr] << 16);
            *(u32x4*)(SVT + (size_t)vr * MR + R0 + kc) = w; }
    }
    __syncthreads();
}

template <int DK, int DK1, int DV, bool MASK, int VAR>
__device__ __forceinline__ void attn_unit(LAS unsigned char* lds, const bf16_t* Qp, int ldq, const bf16_t* K1, int ldk1, const bf16_t* K2, int ldk2, const bf16_t* Vt,
                                          int seg0, int n0t, int seg1, int n1t, int qpos0, int kpos1, float m0, float l0, float scale_log2, bf16_t* Op, int ldo) {
    constexpr int KST = DK * 2, KSZ = 64 * KST, VST = 128, VSZ = DV * VST;
    constexpr int NKC = (64 * DK / 8) / NTH, NVC = (DV * 8) / NTH, NKS = DK / 32, NDT = DV / 16;
    const int tid = opaque_tid(), wave = tid >> 6, lane = tid & 63, fr = lane & 15, g = lane >> 4;
    bf16x8 qf[2][NKS];
#pragma unroll
    for (int qs = 0; qs < 2; ++qs)
#pragma unroll
        for (int ks = 0; ks < NKS; ++ks) qf[qs][ks] = *(const bf16x8*)(Qp + (size_t)(wave * 32 + qs * 16 + fr) * ldq + ks * 32 + g * 8);
    f32x4 O[NDT][2];
#pragma unroll
    for (int dt = 0; dt < NDT; ++dt) { O[dt][0] = (f32x4){0.f, 0.f, 0.f, 0.f}; O[dt][1] = (f32x4){0.f, 0.f, 0.f, 0.f}; }
    float mrun[2] = {m0, m0}, lsum[2] = {g == 0 ? l0 : 0.f, g == 0 ? l0 : 0.f};
    const int nt = n0t + n1t;
    const int grp = ATT_STAGGER ? (wave >> 2) : 1;
    const int wv = __builtin_amdgcn_readfirstlane(wave);
    constexpr int NKW = KSZ / 1024, KWPW = (NKW + 7) / 8, NVW = VSZ / 1024, VWPW = (NVW + 7) / 8;
    static_assert(KSZ % 8192 == 0 && VSZ % 8192 == 0, "tile images are whole wave-loads, equal per wave");
    int koff[KWPW], voff[VWPW]; unsigned ksel = 0u;
#pragma unroll
    for (int i = 0; i < KWPW; ++i) {
        const int wl = wave + 8 * i, o = wl * 1024 + lane * 16, row = o / KST, pc = (o - row * KST) >> 4, ch = (pc & ~7) + ((pc & 7) ^ ((row >> 1) & 7));
        const int srow = (row & 32) + 8 * ((row >> 2) & 3) + 4 * ((row >> 4) & 1) + (row & 3);
        if (ch < DK1 / 8) koff[i] = srow * ldk1 + ch * 8; else { koff[i] = srow * ldk2 + (ch - DK1 / 8) * 8; ksel |= 1u << i; }
    }
#pragma unroll
    for (int i = 0; i < VWPW; ++i) {
        const int wl = wave + 8 * i, o = wl * 1024 + lane * 16, row = o >> 7, pc = (o & 127) >> 4, ch = pc ^ ((row >> 1) & 7);
        voff[i] = row * MR + ch * 8;
    }
    const int swz = (fr >> 1) & 7, offE = (g ^ swz) * 16, offO = ((4 + g) ^ swz) * 16;
#define ATT_DMA_K(trow, buf) do { const bf16_t* b1_ = K1 + (size_t)(trow) * ldk1; const bf16_t* b2_ = (DK1 < DK) ? K2 + (size_t)(trow) * ldk2 : b1_; \
        _Pragma("unroll") for (int i = 0; i < KWPW; ++i) if (koff[i] >= 0) { const bf16_t* src_ = ((DK1 < DK) && ((ksel >> i) & 1u)) ? b2_ + koff[i] : b1_ + koff[i]; \
            __builtin_amdgcn_global_load_lds((const unsigned*)src_, (LAS unsigned*)(lds + (buf) * KSZ + (wv + 8 * i) * 1024), 16, 0, 0); } } while (0)
#define ATT_DMA_V(trow, buf) do { const bf16_t* bv_ = Vt + (trow); \
        _Pragma("unroll") for (int i = 0; i < VWPW; ++i) if (voff[i] >= 0) \
            __builtin_amdgcn_global_load_lds((const unsigned*)(bv_ + voff[i]), (LAS unsigned*)(lds + 2 * KSZ + (buf) * VSZ + (wv + 8 * i) * 1024), 16, 0, 0); } while (0)
#define ATT_VMWAIT asm volatile("s_waitcnt vmcnt(0)" ::: "memory")
#define ATT_ROW(t) ((t) < n0t ? seg0 + (t) * 64 : seg1 + ((t) - n0t) * 64)
#define ATT_BAR do { asm volatile("s_waitcnt lgkmcnt(0)" ::: "memory"); __builtin_amdgcn_s_barrier(); asm volatile("" ::: "memory"); } while (0)
#define ATT_KLD(dst, i) dst = *(const LAS bf16x8*)(kb + ((i) & 3) * 16 * KST + ((i) >> 3) * 128 + ((((i) >> 2) & 1) ? offO : offE))
#define ATT_X(bufk) do { const LAS unsigned char* kb = lds + (bufk) * KSZ + fr * KST; \
        constexpr int XG = 2, NXG = NKS * 4 / XG;     \
        bf16x8 afr[2][XG]; \
        _Pragma("unroll") for (int q = 0; q < XG; ++q) ATT_KLD(afr[0][q], q); \
        _Pragma("unroll") for (int gi = 0; gi < NXG; ++gi) { \
            if (gi + 1 < NXG) { _Pragma("unroll") for (int q = 0; q < XG; ++q) ATT_KLD(afr[(gi + 1) & 1][q], (gi + 1) * XG + q); } \
            __builtin_amdgcn_sched_barrier(0); \
            _Pragma("unroll") for (int q = 0; q < XG; ++q) { const int i_ = gi * XG + q, kt = i_ & 3, ks = i_ >> 2; \
                s[kt][0] = __builtin_amdgcn_mfma_f32_16x16x32_bf16(afr[gi & 1][q], qf[0][ks], ks == 0 ? (f32x4){0.f, 0.f, 0.f, 0.f} : s[kt][0], 0, 0, 0); \
                s[kt][1] = __builtin_amdgcn_mfma_f32_16x16x32_bf16(afr[gi & 1][q], qf[1][ks], ks == 0 ? (f32x4){0.f, 0.f, 0.f, 0.f} : s[kt][1], 0, 0, 0); } \
            __builtin_amdgcn_sched_barrier(0); } } while (0)
    f32x4 s[4][2];
    bf16x8 pf[2][2];
    __syncthreads();
    ATT_DMA_K(ATT_ROW(0), 0); ATT_DMA_V(ATT_ROW(0), 0); ATT_DMA_K(ATT_ROW(1), 1);
    ATT_VMWAIT;
    __syncthreads();
    if (ATT_STAGGER && grp == 1) ATT_BAR;
    ATT_X(0);
    ATT_BAR;
#pragma nounroll
    for (int t = 0; t < nt; ++t) {
        if (grp == 1) { if (t + 2 < nt) ATT_DMA_K(ATT_ROW(t + 2), t & 1); if (t + 1 < nt) ATT_DMA_V(ATT_ROW(t + 1), (t + 1) & 1); }
        const bool masked = MASK && (t >= n0t);
        const int kp0 = kpos1 + (t - n0t) * 64 + g * 8;
        if constexpr (VAR == 5) {
#pragma unroll
        for (int qs = 0; qs < 2; ++qs) {
            float ps = 0.f;
#pragma unroll
            for (int kt = 0; kt < 4; ++kt)
#pragma unroll
                for (int j = 0; j < 4; ++j) ps += s[kt][qs][j];
            lsum[qs] += ps;
#pragma unroll
            for (int s2 = 0; s2 < 2; ++s2) {
                u32x4 w; w.x = cvt_pk_bf16(s[2 * s2][qs][0], s[2 * s2][qs][1]); w.y = cvt_pk_bf16(s[2 * s2][qs][2], s[2 * s2][qs][3]);
                w.z = cvt_pk_bf16(s[2 * s2 + 1][qs][0], s[2 * s2 + 1][qs][1]); w.w = cvt_pk_bf16(s[2 * s2 + 1][qs][2], s[2 * s2 + 1][qs][3]);
                pf[qs][s2] = __builtin_bit_cast(bf16x8, w);
            }
        }
        } else {
#pragma unroll
        for (int qs = 0; qs < 2; ++qs) {
            const int qp = qpos0 + wave * 32 + qs * 16 + fr;
            float mx = -INFINITY;
#pragma unroll
            for (int kt = 0; kt < 4; ++kt)
#pragma unroll
                for (int j = 0; j < 4; ++j) {
                    float v = s[kt][qs][j];
                    if (masked) { const int dlt = kp0 + (kt >> 1) * 32 + (kt & 1) * 4 + j - qp; if (dlt > 128 || dlt < -128) v = -INFINITY; s[kt][qs][j] = v; }
                    mx = fmaxf(mx, v);
                }
            mx = fmaxf(mx, __shfl_xor(mx, 16)); mx = fmaxf(mx, __shfl_xor(mx, 32));
            const float mn = fmaxf(mrun[qs], mx);
            const float al = __builtin_amdgcn_exp2f(mrun[qs] - mn);
            mrun[qs] = mn;
#pragma unroll
            for (int dt = 0; dt < NDT; ++dt) O[dt][qs] = O[dt][qs] * al;
            float ps = 0.f;
#pragma unroll
            for (int kt = 0; kt < 4; ++kt)
#pragma unroll
                for (int j = 0; j < 4; ++j) { const float p = __builtin_amdgcn_exp2f(s[kt][qs][j] - mn); s[kt][qs][j] = p; ps += p; }
            lsum[qs] = lsum[qs] * al + ps;
#pragma unroll
            for (int s2 = 0; s2 < 2; ++s2) {
                u32x4 w; w.x = cvt_pk_bf16(s[2 * s2][qs][0], s[2 * s2][qs][1]); w.y = cvt_pk_bf16(s[2 * s2][qs][2], s[2 * s2][qs][3]);
                w.z = cvt_pk_bf16(s[2 * s2 + 1][qs][0], s[2 * s2 + 1][qs][1]); w.w = cvt_pk_bf16(s[2 * s2 + 1][qs][2], s[2 * s2 + 1][qs][3]);
                pf[qs][s2] = __builtin_bit_cast(bf16x8, w);
            }
        }
        }
        if (grp == 0) ATT_VMWAIT;
        ATT_BAR;
        if (grp == 0) { if (t + 2 < nt) ATT_DMA_K(ATT_ROW(t + 2), t & 1); if (t + 1 < nt) ATT_DMA_V(ATT_ROW(t + 1), (t + 1) & 1); }
        {
            const LAS unsigned char* vb = lds + 2 * KSZ + (t & 1) * VSZ + fr * VST;
            constexpr int NIT = 2 * NDT, GSZ = 2, NGR = NIT / GSZ;
            bf16x8 vf[2][GSZ];
#define ATT_VLD(dst, i) dst = *(const LAS bf16x8*)(vb + ((i) % NDT) * 16 * VST + (((i) / NDT) ? offO : offE))
#pragma unroll
            for (int q = 0; q < GSZ; ++q) ATT_VLD(vf[0][q], q);
#pragma unroll
            for (int gi = 0; gi < NGR; ++gi) {
                if (gi + 1 < NGR) {
#pragma unroll
                    for (int q = 0; q < GSZ; ++q) ATT_VLD(vf[(gi + 1) & 1][q], (gi + 1) * GSZ + q);
                }
                __builtin_amdgcn_sched_barrier(0);
#pragma unroll
                for (int q = 0; q < GSZ; ++q) {
                    const int i = gi * GSZ + q, dt = i % NDT, s2 = i / NDT;
                    O[dt][0] = __builtin_amdgcn_mfma_f32_16x16x32_bf16(vf[gi & 1][q], pf[0][s2], O[dt][0], 0, 0, 0);
                    O[dt][1] = __builtin_amdgcn_mfma_f32_16x16x32_bf16(vf[gi & 1][q], pf[1][s2], O[dt][1], 0, 0, 0);
                }
                __builtin_amdgcn_sched_barrier(0);
            }
#undef ATT_VLD
        }
        if (t + 1 < nt) ATT_X((t + 1) & 1);
        if (grp == 1) ATT_VMWAIT;
        ATT_BAR;
    }
    if (ATT_STAGGER && grp == 0) ATT_BAR;
#pragma unroll
    for (int qs = 0; qs < 2; ++qs) {
        float l = lsum[qs]; l += __shfl_xor(l, 16); l += __shfl_xor(l, 32);
        const float inv = 1.0f / l;
        bf16_t* orow = Op + (size_t)(wave * 32 + qs * 16 + fr) * ldo + g * 4;
#pragma unroll
        for (int dt = 0; dt < NDT; ++dt) *(u32x2*)(orow + dt * 16) = pg8::pack4(O[dt][qs] * inv);
    }
#undef ATT_DMA_K
#undef ATT_DMA_V
#undef ATT_VMWAIT
#undef ATT_ROW
#undef ATT_BAR
#undef ATT_X
#undef ATT_KLD
}

template <int VAR>
__device__ __forceinline__ void phase_attention(LAS unsigned char* lds, const Args& a, int l, bool need_ctx) {
    const bf16_t* P = (const bf16_t*)(a.ws + WS_PROJ); const bf16_t* QB = (const bf16_t*)(a.ws + WS_QB); const bf16_t* KN = (const bf16_t*)(a.ws + WS_KN);
    const bf16_t* VT = (const bf16_t*)(a.ws + WS_VT); const bf16_t* SVT = (const bf16_t*)(a.ws + WS_SVT); bf16_t* Y = (bf16_t*)(a.ws + (VAR ? WS_END : WS_Y));
    const int G = gridDim.x;
    const int nmla = 256 + (need_ctx ? 32 : 0), nswa = 512 + (need_ctx ? 64 : 0);
    const float mla_sc = 0.07216878364870322f * LOG2E, swa_sc = 0.125f * LOG2E;
    for (int un = blockIdx.x; un < nmla + nswa; un += G) {
        if ((VAR == 2 || VAR == 5 || VAR == 6) && un >= nmla) continue;
        if (VAR == 3 && un < nmla) continue;
        if (un < nmla) {
            if (un < 256) {
                const int xcd = un & 7, slot = un >> 3, pair = xcd * 4 + (slot >> 3);
                const int b = pair >> 3, h = pair & 7, qb = slot & 7;
                const int qrow = CR + b * SEQ + qb * 256;
                attn_unit<192, 128, 128, false, VAR>(lds, QB + (size_t)qrow * 1536 + h * 192, 1536, KN + h * 128, 1024, P + 2816, LDP, VT + (size_t)h * 128 * MR,
                                                b * CTXL, 4, CR + b * SEQ, 32, 0, 0, -INFINITY, 0.f, mla_sc, Y + (size_t)qrow * 3072 + 1024 + h * 128, 3072);
            } else {
                const int u2 = un - 256, b = u2 >> 3, h = u2 & 7;
                const int qrow = b * CTXL;
                attn_unit<192, 128, 128, false, VAR>(lds, QB + (size_t)qrow * 1536 + h * 192, 1536, KN + h * 128, 1024, P + 2816, LDP, VT + (size_t)h * 128 * MR,
                                                b * CTXL, 4, 0, 0, 0, 0, -INFINITY, 0.f, mla_sc, Y + (size_t)qrow * 3072 + 1024 + h * 128, 3072);
            }
        } else {
            const int us = un - nmla;
            if (us < 512) {
                const int xcd = us & 7, slot = ((us >> 3) & 31) + 32 * (us >> 8), pair = xcd * 2 + (slot >> 5);
                const int b = pair >> 2, gk = pair & 3, h = gk * 4 + ((slot >> 3) & 3), qb = slot & 7;
                const int q0 = qb * 256, qrow = CR + b * SEQ + q0;
                const int ks = q0 >= 128 ? q0 - 128 : 0, ke = q0 + 384 < SEQ ? q0 + 384 : SEQ;
                const float sink = a.in[18][l * 16 + h] * LOG2E;
                attn_unit<64, 64, 64, true, VAR>(lds, P + (size_t)qrow * LDP + 2880 + h * 64, LDP, P + 3904 + gk * 64, LDP, nullptr, 0, SVT + (size_t)gk * 64 * MR,
                                            b * CTXL, 4, CR + b * SEQ + ks, (ke - ks) >> 6, q0, ks, sink, 1.0f, swa_sc, Y + (size_t)qrow * 3072 + 2048 + h * 64, 3072);
            } else {
                const int u2 = us - 512, b = u2 >> 4, h = u2 & 15, gk = h >> 2;
                const int qrow = b * CTXL;
                const float sink = a.in[18][l * 16 + h] * LOG2E;
                attn_unit<64, 64, 64, true, VAR>(lds, P + (size_t)qrow * LDP + 2880 + h * 64, LDP, P + 3904 + gk * 64, LDP, nullptr, 0, SVT + (size_t)gk * 64 * MR,
                                            b * CTXL, 4, 0, 0, 0, 0, sink, 1.0f, swa_sc, Y + (size_t)qrow * 3072 + 2048 + h * 64, 3072);
            }
        }
    }
}

__device__ __forceinline__ float gelu_tanh(float x) {
    const float u2 = 1.5957691216057308f * (x + 0.044715f * x * x * x);
    return x * __builtin_amdgcn_rcpf(1.0f + __builtin_amdgcn_exp2f(-u2 * LOG2E));
}
__device__ __forceinline__ void chunk_info(int ck, int& b, int& cs, int& seqrow0, int& seqlen) {
    if (ck < 16) { b = ck >> 2; cs = ck & 3; seqrow0 = b * CTXL; seqlen = CTXL; } else { const int k2 = ck - 16; b = k2 >> 5; cs = k2 & 31; seqrow0 = CR + b * SEQ; seqlen = SEQ; }
}
__device__ __forceinline__ void lruA_prefetch(const bf16_t* P, int ck, int n, int tid, u32x4 (&raw)[3]) {
    int b, cs, seqrow0, seqlen; chunk_info(ck, b, cs, seqrow0, seqlen);
#pragma unroll
    for (int i = 0; i < 3; ++i) {
        const int idx = tid + i * NTH, rr = idx >> 4, c8 = (idx & 15) * 8, tp = cs * 64 + rr - 2;
        raw[i] = (u32x4){0u, 0u, 0u, 0u};
        if (idx < 67 * 16 && tp >= 0 && tp < seqlen) raw[i] = *(const u32x4*)(P + (size_t)(seqrow0 + tp) * LDP + n * 128 + c8);
    }
}
__device__ __forceinline__ void lruA_unit(LAS unsigned char* lds, const Args& a, int l, int ck, int n, u32x4 (&raw)[3], int nck, int nn, bool has_next, int dmask) {
    LAS float* Xraw = (LAS float*)lds;
    LAS bf16_t* Xb = (LAS bf16_t*)(lds + 34304);
    LAS float* Ab = (LAS float*)(lds + 51712);
    LAS float* Bb = (LAS float*)(lds + 84480);
    LAS float* SegP = (LAS float*)(lds + 117248); LAS float* SegH = SegP + 512; LAS float* CarP = SegP + 1024; LAS float* CarH = SegP + 1536;
    const bf16_t* P = (const bf16_t*)(a.ws + WS_PROJ);
    bf16_t* HL = (bf16_t*)(a.ws + WS_U); bf16_t* PC = (bf16_t*)(a.ws + WS_MB);
    f32x2* SUM = (f32x2*)(a.ws + WS_SUM);
    const bf16_t* WL = (const bf16_t*)(a.ws + (size_t)l * W_LAYER + OW_LRU);
    const int tid = opaque_tid(), wave = tid >> 6, lane = tid & 63, fr = lane & 15, g = lane >> 4;
    int b, cs, seqrow0, seqlen; chunk_info(ck, b, cs, seqrow0, seqlen);
    const int R0 = seqrow0 + cs * 64;
    __syncthreads();
#pragma unroll
    for (int i = 0; i < 3; ++i) {
        const int idx = tid + i * NTH, rr = idx >> 4, c8 = (idx & 15) * 8;
        if (idx < 67 * 16) { LAS float* d = Xraw + rr * 128 + c8; const u32x4 w = raw[i];
            d[0] = bflo(w.x); d[1] = bfhi(w.x); d[2] = bflo(w.y); d[3] = bfhi(w.y); d[4] = bflo(w.z); d[5] = bfhi(w.z); d[6] = bflo(w.w); d[7] = bfhi(w.w); }
    }
    const int ko = wave * 16 + fr, cch = n * 128 + ko;
    bf16x8 wf[2][2][4];
#pragma unroll
    for (int d = 0; d < 2; ++d)
#pragma unroll
        for (int ri = 0; ri < 2; ++ri)
#pragma unroll
            for (int ks = 0; ks < 4; ++ks) wf[d][ri][ks] = *(const bf16x8*)(WL + ((size_t)((d * 2 + ri) * 8 + n) * 128 + ko) * 128 + ks * 32 + g * 8);
    __syncthreads();
    {
        const int ch = tid & 127, tq = tid >> 7, c2 = n * 128 + ch;
        const float* cw = a.in[7] + (size_t)l * 4 * 1024 + c2;
        const float w0 = cw[0], w1 = cw[1024], w2 = cw[2048], w3 = cw[3072], cb = a.in[8][l * 1024 + c2];
#pragma unroll 4
        for (int i = 0; i < 16; ++i) { const int t = tq * 16 + i;
            const float x = w0 * Xraw[t * 128 + ch] + w1 * Xraw[(t + 1) * 128 + ch] + w2 * Xraw[(t + 2) * 128 + ch] + w3 * Xraw[(t + 3) * 128 + ch] + cb;
            Xb[t * 136 + ch] = (bf16_t)(cvt_pk_bf16(x, 0.f) & 0xffffu); }
    }
    if (has_next) lruA_prefetch(P, nck, nn, tid, raw);
    __syncthreads();
#pragma unroll
    for (int d = 0; d < 2; ++d) {
        if (!((dmask >> d) & 1)) continue;
        {
            f32x4 ar[4], ai[4];
#pragma unroll
            for (int tt = 0; tt < 4; ++tt) { ar[tt] = (f32x4){0.f, 0.f, 0.f, 0.f}; ai[tt] = (f32x4){0.f, 0.f, 0.f, 0.f}; }
            bf16x8 xa[4][4];
#pragma unroll
            for (int ks = 0; ks < 4; ++ks)
#pragma unroll
                for (int tt = 0; tt < 4; ++tt) xa[ks][tt] = *(const LAS bf16x8*)(Xb + (tt * 16 + fr) * 136 + ks * 32 + g * 8);
            bf16_t xv[4][4];
#pragma unroll
            for (int tt = 0; tt < 4; ++tt)
#pragma unroll
                for (int j = 0; j < 4; ++j) xv[tt][j] = Xb[(tt * 16 + g * 4 + j) * 136 + ko];
            __builtin_amdgcn_sched_barrier(0);
#pragma unroll
            for (int ks = 0; ks < 4; ++ks)
#pragma unroll
                for (int tt = 0; tt < 4; ++tt) {
                    ar[tt] = __builtin_amdgcn_mfma_f32_16x16x32_bf16(xa[ks][tt], wf[d][0][ks], ar[tt], 0, 0, 0);
                    ai[tt] = __builtin_amdgcn_mfma_f32_16x16x32_bf16(xa[ks][tt], wf[d][1][ks], ai[tt], 0, 0, 0);
                }
            const float biasr = a.in[10][(size_t)(l * 2 + d) * 1024 + cch] * -LOG2E, biasi = a.in[12][(size_t)(l * 2 + d) * 1024 + cch] * -LOG2E;
            const float sp8 = 8.0f * log1pf(__expf(-a.in[13][(size_t)(l * 2 + d) * 1024 + cch]));
#pragma unroll
            for (int tt = 0; tt < 4; ++tt)
#pragma unroll
                for (int j = 0; j < 4; ++j) {
                    const int tok = tt * 16 + g * 4 + j;
                    const float r = __builtin_amdgcn_rcpf(1.0f + __builtin_amdgcn_exp2f(ar[tt][j] * -LOG2E + biasr));
                    const float ig = __builtin_amdgcn_rcpf(1.0f + __builtin_amdgcn_exp2f(ai[tt][j] * -LOG2E + biasi));
                    const float la = -sp8 * r, aa = __builtin_amdgcn_exp2f(la * LOG2E), z = 2.0f * la;
                    const float ser = -z * (1.0f + z * (0.5f + z * (0.16666667f + z * (0.041666668f + z * (0.0083333338f + z * 0.0013888889f)))));
                    const float em = z > -0.25f ? ser : 1.0f - aa * aa;
                    Ab[tok * 128 + ko] = aa; Bb[tok * 128 + ko] = __builtin_amdgcn_sqrtf(em) * ig * bf2f(xv[tt][j]);
                }
        }
        __syncthreads();
        const int seg = tid >> 7, ch = tid & 127;
        {
            float cp = 1.f, h = 0.f;
#pragma unroll
            for (int i = 0; i < 16; ++i) { const int t = d ? seg * 16 + 15 - i : seg * 16 + i; const float aa = Ab[t * 128 + ch]; h = aa * h + Bb[t * 128 + ch]; cp *= aa; Ab[t * 128 + ch] = cp; Bb[t * 128 + ch] = h; }
            SegP[seg * 128 + ch] = cp; SegH[seg * 128 + ch] = h;
        }
        __syncthreads();
        {
            float cP = 1.f, cH = 0.f;
            if (d == 0) { for (int s2 = 0; s2 < seg; ++s2) { const float p = SegP[s2 * 128 + ch]; cH = p * cH + SegH[s2 * 128 + ch]; cP *= p; } }
            else { for (int s2 = 3; s2 > seg; --s2) { const float p = SegP[s2 * 128 + ch]; cH = p * cH + SegH[s2 * 128 + ch]; cP *= p; } }
            CarP[seg * 128 + ch] = cP; CarH[seg * 128 + ch] = cH;
            if (seg == (d ? 0 : 3)) { const float p = SegP[seg * 128 + ch]; SUM[((size_t)(d * 144 + ck)) * 1024 + n * 128 + ch] = (f32x2){p * cP, p * cH + SegH[seg * 128 + ch]}; }
        }
        __syncthreads();
#pragma unroll
        for (int p = 0; p < 2; ++p) {
            const int idx = tid + p * NTH, tok = idx >> 4, c8 = (idx & 15) * 8, sg = tok >> 4;
            float hl[8], pc[8];
#pragma unroll
            for (int e = 0; e < 8; ++e) { const float pl = Ab[tok * 128 + c8 + e]; hl[e] = Bb[tok * 128 + c8 + e] + pl * CarH[sg * 128 + c8 + e]; pc[e] = pl * CarP[sg * 128 + c8 + e]; }
            u32x4 wh, wp;
            wh.x = cvt_pk_bf16(hl[0], hl[1]); wh.y = cvt_pk_bf16(hl[2], hl[3]); wh.z = cvt_pk_bf16(hl[4], hl[5]); wh.w = cvt_pk_bf16(hl[6], hl[7]);
            wp.x = cvt_pk_bf16(pc[0], pc[1]); wp.y = cvt_pk_bf16(pc[2], pc[3]); wp.z = cvt_pk_bf16(pc[4], pc[5]); wp.w = cvt_pk_bf16(pc[6], pc[7]);
            const size_t o = ((size_t)d * MR + R0 + tok) * 1024 + n * 128 + c8;
            *(u32x4*)(HL + o) = wh; *(u32x4*)(PC + o) = wp;
        }
        if (d == 0 && (dmask & 2)) __syncthreads();
    }
}
__device__ __forceinline__ void phase_lruA(LAS unsigned char* lds, const Args& a, int l) {
    const int G = gridDim.x, tid = opaque_tid();
    const int NU = 144 * 8, nfull = (NU / G) * G, nwork = nfull + 2 * (NU - nfull);
    const bf16_t* P = (const bf16_t*)(a.ws + WS_PROJ);
    u32x4 raw[3];
#define LRUA_DECODE(w, un, dm) do { if ((w) < nfull) { un = (w); dm = 3; } else { const int h_ = (w) - nfull; un = nfull + (h_ >> 1); dm = 1 << (h_ & 1); } } while (0)
    int w = blockIdx.x;
    if (w < nwork) { int un, dm; LRUA_DECODE(w, un, dm); lruA_prefetch(P, un >> 3, un & 7, tid, raw); }
    for (; w < nwork; w += G) {
        int un, dm; LRUA_DECODE(w, un, dm);
        const int wn = w + G; int un2 = 0, dm2 = 0; if (wn < nwork) LRUA_DECODE(wn, un2, dm2);
        lruA_unit(lds, a, l, un >> 3, un & 7, raw, un2 >> 3, un2 & 7, wn < nwork, dm);
    }
#undef LRUA_DECODE
    __syncthreads();
}

__device__ __forceinline__ void lruC_unit(LAS unsigned char* lds, const Args& a, int ck, int n) {
    LAS float* Car = (LAS float*)lds;
    const bf16_t* P = (const bf16_t*)(a.ws + WS_PROJ); bf16_t* Y = (bf16_t*)(a.ws + WS_Y);
    const bf16_t* HL = (const bf16_t*)(a.ws + WS_U); const bf16_t* PC = (const bf16_t*)(a.ws + WS_MB);
    const f32x2* SUM = (const f32x2*)(a.ws + WS_SUM);
    const int tid = opaque_tid();
    int b, cs, seqrow0, seqlen; chunk_info(ck, b, cs, seqrow0, seqlen);
    const int R0 = seqrow0 + cs * 64;
    u32x4 h0[2], p0[2], h1[2], p1[2], ag[2];
#pragma unroll
    for (int p = 0; p < 2; ++p) {
        const int idx = tid + p * NTH, tok = idx >> 4, c8 = (idx & 15) * 8;
        const size_t o = ((size_t)R0 + tok) * 1024 + n * 128 + c8;
        h0[p] = *(const u32x4*)(HL + o); p0[p] = *(const u32x4*)(PC + o); h1[p] = *(const u32x4*)(HL + (size_t)MR * 1024 + o); p1[p] = *(const u32x4*)(PC + (size_t)MR * 1024 + o);
        ag[p] = *(const u32x4*)(P + (size_t)(R0 + tok) * LDP + 1024 + n * 128 + c8);
    }
    __syncthreads();
    if (tid < 256) {
        const int d = tid >> 7, ch = tid & 127;
        const bool isctx = ck < 16;
        const int np = d == 0 ? (isctx ? cs : 4 + cs) : (isctx ? 3 - cs : 35 - cs);
        float carry = 0.f;
        for (int j0 = 0; j0 < np; j0 += 12) {
            f32x2 v[12];
#pragma unroll
            for (int q = 0; q < 12; ++q) {
                const int j = j0 + q; int cc;
                if (d == 0) cc = isctx ? b * 4 + j : (j < 4 ? b * 4 + j : 16 + b * 32 + (j - 4));
                else cc = isctx ? b * 4 + 3 - j : (j < 4 ? b * 4 + 3 - j : 16 + b * 32 + 31 - (j - 4));
                v[q] = (f32x2){1.f, 0.f};
                if (j < np) v[q] = SUM[((size_t)(d * 144 + cc)) * 1024 + n * 128 + ch];
            }
#pragma unroll
            for (int q = 0; q < 12; ++q) carry = v[q].x * carry + v[q].y;
        }
        Car[tid] = carry;
    }
    __syncthreads();
#pragma unroll
    for (int p = 0; p < 2; ++p) {
        const int idx = tid + p * NTH, tok = idx >> 4, c8 = (idx & 15) * 8;
        const LAS float* cf = Car + c8; const LAS float* cb = Car + 128 + c8;
        float y[8];
#define LRUC_E(e, hw0, pw0, hw1, pw1, gw, HI) y[e] = ((HI ? bfhi(hw0) : bflo(hw0)) + (HI ? bfhi(pw0) : bflo(pw0)) * cf[e] + (HI ? bfhi(hw1) : bflo(hw1)) + (HI ? bfhi(pw1) : bflo(pw1)) * cb[e]) * gelu_tanh(HI ? bfhi(gw) : bflo(gw))
        LRUC_E(0, h0[p].x, p0[p].x, h1[p].x, p1[p].x, ag[p].x, 0); LRUC_E(1, h0[p].x, p0[p].x, h1[p].x, p1[p].x, ag[p].x, 1);
        LRUC_E(2, h0[p].y, p0[p].y, h1[p].y, p1[p].y, ag[p].y, 0); LRUC_E(3, h0[p].y, p0[p].y, h1[p].y, p1[p].y, ag[p].y, 1);
        LRUC_E(4, h0[p].z, p0[p].z, h1[p].z, p1[p].z, ag[p].z, 0); LRUC_E(5, h0[p].z, p0[p].z, h1[p].z, p1[p].z, ag[p].z, 1);
        LRUC_E(6, h0[p].w, p0[p].w, h1[p].w, p1[p].w, ag[p].w, 0); LRUC_E(7, h0[p].w, p0[p].w, h1[p].w, p1[p].w, ag[p].w, 1);
#undef LRUC_E
        u32x4 w; w.x = cvt_pk_bf16(y[0], y[1]); w.y = cvt_pk_bf16(y[2], y[3]); w.z = cvt_pk_bf16(y[4], y[5]); w.w = cvt_pk_bf16(y[6], y[7]);
        *(u32x4*)(Y + (size_t)(R0 + tok) * 3072 + n * 128 + c8) = w;
    }
}
__device__ __forceinline__ void phase_lruC(LAS unsigned char* lds, const Args& a, int ck0, int skew) {
    const int G = gridDim.x, nun = (144 - ck0) * 8;
    int first = (int)blockIdx.x - (skew % G); if (first < 0) first += G;
    for (int un = first; un < nun; un += G) lruC_unit(lds, a, ck0 + (un >> 3), un & 7);
    __syncthreads();
}

#define XB_TMO      128
#define XB_XCNT(j)  (256  + 64 * (j))
#define XB_XSUB(j)  (1280 + 64 * (j))
#define XB_XGEN(j)  (2304 + 64 * (j))
#define XB_TOP      3328
#define XB_TOPGEN   3392
#define XCD_BAR_WORDS 3456
#define XB_SPIN_CAP (1u << 18)
__device__ __forceinline__ unsigned xb_ld(unsigned* p)              { return __hip_atomic_load(p, __ATOMIC_RELAXED, __HIP_MEMORY_SCOPE_AGENT); }
__device__ __forceinline__ unsigned xb_add(unsigned* p, unsigned v) { return __hip_atomic_fetch_add(p, v, __ATOMIC_RELAXED, __HIP_MEMORY_SCOPE_AGENT); }
__device__ __forceinline__ unsigned xb_xcc_id() { return (unsigned)__builtin_amdgcn_s_getreg((3 << 11) | 20) & 0xFu; }
#define XB_SPIN(cond, bar) do { unsigned _sp = 0; while (cond) { __builtin_amdgcn_s_sleep(1); \
    if ((++_sp & 255u) == 0u) { if (xb_ld(&(bar)[XB_TMO])) break; if (_sp > XB_SPIN_CAP) { atomicAdd(&(bar)[XB_TMO], 1u); break; } } } } while (0)
struct XcdBarrier { unsigned* bar; unsigned x; volatile LAS unsigned* st; };
__device__ __forceinline__ XcdBarrier xcd_barrier_post(unsigned* bar, volatile LAS unsigned* st) {
    XcdBarrier b; b.bar = bar; b.x = xb_xcc_id(); b.st = st;
    if (threadIdx.x == 0) (void)xb_add(&bar[XB_XCNT(b.x)], 1u);
    return b;
}
__device__ __forceinline__ void xcd_barrier_complete(unsigned* bar, unsigned x, unsigned& nloc, unsigned& nx) {
    const unsigned G = gridDim.x * gridDim.y * gridDim.z;
    unsigned sum, cnt, mine, sp = 0u;
    for (;;) {
        sum = 0u; cnt = 0u; mine = 0u;
#pragma unroll
        for (unsigned j = 0; j < 16; ++j) { const unsigned c = xb_ld(&bar[XB_XCNT(j)]); sum += c; cnt += (c > 0u) ? 1u : 0u; mine = (j == x) ? c : mine; }
        if (sum == G) break;
        __builtin_amdgcn_s_sleep(1);
        if ((++sp & 255u) == 0u) { if (xb_ld(&bar[XB_TMO])) break; if (sp > XB_SPIN_CAP) { atomicAdd(&bar[XB_TMO], 1u); break; } }
    }
    nloc = mine > 0u ? mine : 1u; nx = cnt > 0u ? cnt : 1u;
}
__device__ __forceinline__ void xcd_barrier(const XcdBarrier& b) {
    asm volatile("s_waitcnt vmcnt(0)" ::: "memory");
    __syncthreads();
    if (threadIdx.x == 0) {
        unsigned* bar = b.bar;
        __builtin_amdgcn_s_waitcnt(0);
        unsigned nloc = b.st[0], nx = b.st[1];
        if (nloc == 0u) { xcd_barrier_complete(bar, b.x, nloc, nx); b.st[0] = nloc; b.st[1] = nx; }
        const unsigned old = xb_add(&bar[XB_XSUB(b.x)], 1u);
        const unsigned gen = old / nloc;
        if (old + 1u == (gen + 1u) * nloc) {
            __builtin_amdgcn_fence(__ATOMIC_RELEASE, "agent");
            asm volatile("s_waitcnt vmcnt(0)" ::: "memory");
            const unsigned og = xb_add(&bar[XB_TOP], 1u);
            const unsigned tg = og / nx;
            if (og + 1u == (tg + 1u) * nx) xb_add(&bar[XB_TOPGEN], 1u);
            else XB_SPIN(xb_ld(&bar[XB_TOPGEN]) == tg, bar);
            __builtin_amdgcn_fence(__ATOMIC_ACQUIRE, "agent");
            xb_add(&bar[XB_XGEN(b.x)], 1u);
            asm volatile("s_waitcnt vmcnt(0)" ::: "memory");
        } else {
            XB_SPIN(xb_ld(&bar[XB_XGEN(b.x)]) == gen, bar);
            __builtin_amdgcn_fence(__ATOMIC_ACQUIRE, "agent");
            asm volatile("s_waitcnt vmcnt(0)" ::: "memory");
        }
    }
    __syncthreads();
}

__global__ void __launch_bounds__(NTH) mega(Args a) {
    extern __shared__ __attribute__((aligned(16))) unsigned char lds_raw[];
    LAS unsigned char* lds = (LAS unsigned char*)lds_raw;
    cg::grid_group grid = cg::this_grid();
    if (threadIdx.x < 16) ((LAS unsigned*)(lds + 131072))[threadIdx.x] = 0u;
    __syncthreads();
    XcdBarrier xbar = xcd_barrier_post((unsigned*)(a.ws + WS_BAR), (volatile LAS unsigned*)(lds + 131072));
    const int G = gridDim.x, c = blockIdx.x;
    int ph = 0;
#ifndef SUB
#define SUB 0xFF
#endif
#ifndef PHMASK
#define PHMASK 0xFFFF
#endif
#ifndef ATTVAR
#define ATTVAR 2
#endif
#ifndef REPSUB
#define REPSUB 0
#endif
#ifndef REPMASK
#define REPMASK 0
#endif
#define PHASE_BEGIN(id) if ((((PHMASK) >> (id)) & 1) && ph >= a.ph_lo && ph < a.ph_hi) { for (int rep_ = 0; rep_ <= (((REPMASK) >> (id)) & 1); ++rep_) {
#ifndef REPSYNC
#define REPSYNC 0
#endif
#define PHASE_END   } if (ph + 1 < a.ph_hi) { if (a.ph_lo < 0) grid.sync(); for (int rs_ = 0; rs_ <= REPSYNC; ++rs_) xcd_barrier(xbar); } } ++ph;
    unsigned char* ws = a.ws;
    bf16_t* PROJ = (bf16_t*)(ws + WS_PROJ); bf16_t* U = (bf16_t*)(ws + WS_U); bf16_t* Y = (bf16_t*)(ws + WS_Y); bf16_t* QB = (bf16_t*)(ws + WS_QB);
    bf16_t* KN = (bf16_t*)(ws + WS_KN); bf16_t* VT = (bf16_t*)(ws + WS_VT); bf16_t* MB = (bf16_t*)(ws + WS_MB); bf16_t* H = PROJ;
    float* PART4 = (float*)(ws + WS_QB);
    float* PART = (float*)(ws + WS_Y);
    float* XV = (float*)(ws + WS_XV); float* ADA = (float*)(ws + WS_ADA); float* RMS = (float*)(ws + WS_RMS); const float* ROPE = (const float*)(ws + WS_ROPE);

    PHASE_BEGIN(0)
        phase_ada(lds, a); phase_rope_table(a); phase_convert(lds, a);
    PHASE_END
    PHASE_BEGIN(1)
        phase_init_u(a);
    PHASE_END
#pragma nounroll
    for (int l = 0; l < 2; ++l) {
        const bool need_ctx = (l == 0);
        const unsigned char* wl = ws + (size_t)l * W_LAYER;
        const int pm_lo = need_ctx ? 0 : 4, nMl = need_ctx ? 36 : 32;
        PHASE_BEGIN(2)
            pg8::Gemm g{U, (const bf16_t*)(wl + OW_IN), 2048, 2048, 2048, 0, 0};
            pg8::Sched<1> S; S.G = G; S.c = c;
            if (need_ctx) { S.a.init(36, 42, 0, 0); S.b.init(0, 1, 0, 0); } else { S.a.init(32, 42, 4, 0); S.b.init(4, 18, 0, 0); }
            pg8::EpiProj E{PROJ, ROPE, RMS};
            pg8::gemm_phase(lds, g, S, E);
        PHASE_END
        PHASE_BEGIN(3)
            if (SUB & 1) { pg8::Gemm g{PROJ + 2048, (const bf16_t*)(wl + OW_Q), LDP, 512, 512, 0, 0}; pg8::Sched<1> S; S.G = G; S.c = c; S.a.init(nMl, 6, pm_lo, 0); S.b.init(0, 1, 0, 0);
              pg8::EpiQ E{QB, ROPE, RMS}; pg8::gemm_phase(lds, g, S, E); }
            if (SUB & 2) { pg8::Gemm g{PROJ + 2560, (const bf16_t*)(wl + OW_K), LDP, 256, 256, 0, 0}; pg8::Sched<1> S; S.G = G; S.c = (c + G - (nMl * 6) % G) % G; S.a.init(36, 4, 0, 0); S.b.init(0, 1, 0, 0);
              pg8::EpiKN E{KN, RMS}; pg8::gemm_phase(lds, g, S, E); }
            if (SUB & 4) { pg8::Gemm g{(const bf16_t*)(wl + OW_V), PROJ + 2560, 256, LDP, 256, 0, 0}; pg8::Sched<1> S; S.G = G; S.c = (c + G - (nMl * 6 + 144) % G) % G; S.a.init(4, 36, 0, 0); S.b.init(0, 1, 0, 0);
              pg8::EpiVT E{VT, RMS}; pg8::gemm_phase(lds, g, S, E); }
            if (SUB & 8) phase_svt(lds, a);
            for (int r2 = 0; r2 <= ((REPSUB >> 4) & 1); ++r2) phase_lruA(lds, a, l);
        PHASE_END
        PHASE_BEGIN(4)
            phase_attention<0>(lds, a, l, need_ctx); if ((REPSUB >> 5) & 1) phase_attention<ATTVAR>(lds, a, l, need_ctx);
            for (int r2 = 0; r2 <= ((REPSUB >> 6) & 1); ++r2) phase_lruC(lds, a, need_ctx ? 0 : 16, 64);
        PHASE_END
        PHASE_BEGIN(5)
            { pg8::Gemm g{Y, (const bf16_t*)(wl + OW_BR), 3072, 1024, 1024, 1024 * 2, (long)2048 * 1024 * 2};
              pg8::Sched<3> S; S.G = G; S.c = c; S.a.init(32, 8, 4, 0); S.b.init(0, 1, 0, 0);
              pg8::EpiMerge E{MB, PROJ};
              pg8::gemm_phase(lds, g, S, E); }
            if (need_ctx) {
#pragma nounroll
              for (int kh = 0; kh < 2; ++kh) {
                pg8::Gemm g{Y + kh * 512, (const bf16_t*)(wl + OW_BR) + kh * 512, 3072, 1024, 512, 1024 * 2, (long)2048 * 1024 * 2};
                pg8::Sched<3, true> S; S.G = G; S.c = (c + 96 + kh * 128) % G; S.a.init(4, 8, 0, 0); S.b.init(0, 1, 0, 0);
                pg8::EpiPartial E{PART4 + (size_t)kh * 3 * CR * 2048};
                pg8::gemm_phase(lds, g, S, E); }
            }
        PHASE_END
        if (need_ctx) {
        PHASE_BEGIN(11)
            const int tid_ = opaque_tid();
            for (int ch = blockIdx.x * NTH + tid_; ch < CR * 256; ch += G * NTH) {
                const int R = ch >> 8, c8 = (ch & 255) * 8;
                f32x4 m0 = (f32x4){0.f, 0.f, 0.f, 0.f}, m1 = (f32x4){0.f, 0.f, 0.f, 0.f};
#pragma unroll
                for (int br = 0; br < 3; ++br) {
                    const float* p0 = PART4 + ((size_t)br * CR + R) * 2048 + c8; const float* p1 = PART4 + ((size_t)(3 + br) * CR + R) * 2048 + c8;
                    const f32x4 a0 = *(const f32x4*)p0 + *(const f32x4*)p1, a1 = *(const f32x4*)(p0 + 4) + *(const f32x4*)(p1 + 4);
                    const u32x4 gw = *(const u32x4*)(PROJ + (size_t)R * LDP + 4416 + br * 2048 + c8);
                    m0[0] += a0[0] * sigmoidf_(bflo(gw.x)); m0[1] += a0[1] * sigmoidf_(bfhi(gw.x)); m0[2] += a0[2] * sigmoidf_(bflo(gw.y)); m0[3] += a0[3] * sigmoidf_(bfhi(gw.y));
                    m1[0] += a1[0] * sigmoidf_(bflo(gw.z)); m1[1] += a1[1] * sigmoidf_(bfhi(gw.z)); m1[2] += a1[2] * sigmoidf_(bflo(gw.w)); m1[3] += a1[3] * sigmoidf_(bfhi(gw.w));
                }
                *(u32x4*)(MB + (size_t)R * 2048 + c8) = pg8::pack8(m0, m1);
            }
        PHASE_END
        }
        PHASE_BEGIN(6)
            { pg8::Gemm g{MB, (const bf16_t*)(wl + OW_OUT), 2048, 2048, 2048, 0, 0};
              pg8::Sched<1> S; S.G = G; S.c = c; S.a.init(32, 8, 4, 0); S.b.init(0, 1, 0, 0);
              pg8::EpiRes E{XV, ADA + (size_t)l * 5 * 12288 + 4096};
              pg8::gemm_phase(lds, g, S, E); }
            if (need_ctx) {
              pg8::Gemm g{MB, (const bf16_t*)(wl + OW_OUT), 2048, 2048, 256, 256 * 2, 256 * 2};
              pg8::Sched<8, true> S; S.G = G; S.c = c; S.a.init(4, 8, 0, 0); S.b.init(0, 1, 0, 0);
              pg8::EpiPartial E{PART};
              pg8::gemm_phase(lds, g, S, E); }
        PHASE_END
        PHASE_BEGIN(7)
            phase_ln(a, need_ctx ? 0 : CR, a.in[21] + l * 2048, a.in[22] + l * 2048, ADA + (size_t)l * 5 * 12288 + 6144, nullptr, PART, need_ctx ? 8 : 0, ADA + (size_t)(l * 5 + 4) * 12288 + 4096);
        PHASE_END
        PHASE_BEGIN(8)
            pg8::Gemm g{U, (const bf16_t*)(wl + OW_F1), 2048, 2048, 2048, 0, 0};
            pg8::Sched<1> S; S.G = G; S.c = c; S.a.init(nMl, 44, pm_lo, 0); S.b.init(0, 1, 0, 0);
            pg8::EpiSwiglu E{H};
            pg8::gemm_phase(lds, g, S, E);
        PHASE_END
        PHASE_BEGIN(9)
            { pg8::Gemm g{H, (const bf16_t*)(wl + OW_F2), FF, FF, FF, 0, 0};
              pg8::Sched<1> S; S.G = G; S.c = c; S.a.init(32, 8, 4, 0); S.b.init(0, 1, 0, 0);
              pg8::EpiRes E{XV, ADA + (size_t)l * 5 * 12288 + 10240};
              pg8::gemm_phase(lds, g, S, E); }
            if (need_ctx) {
              pg8::Gemm g{H, (const bf16_t*)(wl + OW_F2), FF, FF, 1408, 1408 * 2, 1408 * 2};
              pg8::Sched<4, true> S; S.G = G; S.c = c; S.a.init(4, 8, 0, 0); S.b.init(0, 1, 0, 0);
              pg8::EpiPartial E{PART};
              pg8::gemm_phase(lds, g, S, E); }
        PHASE_END
        PHASE_BEGIN(10)
            if (need_ctx) phase_ln(a, 0, a.in[25] + l * 2048, a.in[26] + l * 2048, ADA + (size_t)(l + 1) * 5 * 12288, nullptr, PART, 4, ADA + (size_t)(l * 5 + 4) * 12288 + 10240);
            else phase_ln(a, CR, a.in[25] + l * 2048, a.in[26] + l * 2048, nullptr, a.out);
        PHASE_END
    }
#undef PHASE_BEGIN
#undef PHASE_END
}

constexpr int N_PHASES = 2 + 2 * 9 + 1;

extern "C" void kernel_launch(void* const* d_in, const int* in_sizes, int n_in, void* d_out, int out_size, void* d_ws, size_t ws_size, hipStream_t stream) {
    static int grid = 0;
    if (grid == 0) {
        if (n_in != 27 || ws_size < WS_END) { fprintf(stderr, "kernel_launch: unexpected n_in %d or ws_size %zu (< %zu)\n", n_in, ws_size, (size_t)WS_END); grid = -1; return; }
        int dev = 0, cus = 0, per_cu = 0;
        hipGetDevice(&dev);
        hipDeviceGetAttribute(&cus, hipDeviceAttributeMultiprocessorCount, dev);
        hipFuncSetAttribute((const void*)mega, hipFuncAttributeMaxDynamicSharedMemorySize, LDS_BYTES);
        hipOccupancyMaxActiveBlocksPerMultiprocessor(&per_cu, (const void*)mega, NTH, LDS_BYTES);
        if (per_cu < 1) per_cu = 1;
        grid = cus * 1;
        (void)hipGetLastError();
    }
    if (grid < 0) return;
    (void)hipMemsetAsync((unsigned char*)d_ws + WS_BAR, 0, 16384, stream);
    Args a{};
    for (int i = 0; i < 27; ++i) a.in[i] = (const float*)d_in[i];
    a.out = (float*)d_out; a.ws = (unsigned char*)d_ws; a.ph_lo = 0; a.ph_hi = N_PHASES;
    void* args[] = {&a};
    hipError_t e = hipLaunchCooperativeKernel((const void*)mega, dim3(grid), dim3(NTH), args, LDS_BYTES, stream);
    if (e != hipSuccess) fprintf(stderr, "cooperative launch failed: %s (grid %d)\n", hipGetErrorString(e), grid);
}
```
